# Optimizing an MI355X kernel written in HIP

```python
import jax, jax.numpy as jnp
from jax import lax
import numpy as np

D_MODEL = 1024
BATCH = 32
SEQ = 256
DEPTH = 2
DEC_BATCH = 2
DEC_SEQ = 4096
PAST_LEN = 512

GRID_W = 64
N_RET_HEADS = 4
RET_DK = 128
RET_DV = 128
RET_CHUNK = 128
N_HEADS = 8
N_KV_HEADS = 2
HEAD_DIM = 64
Q_BLOCK = 128
ROPE_THETA = 10000.0
CONV_DIM = 512
CONV_K = 3
FFN_DIM = 2816
N_MOD = 9
EPS = 1e-6
RET_QK_W = N_RET_HEADS * RET_DK
RET_V_W = N_RET_HEADS * RET_DV
ATT_Q_W = N_HEADS * HEAD_DIM
ATT_KV_W = N_KV_HEADS * HEAD_DIM
IN_SIZES = (RET_QK_W, RET_QK_W, RET_V_W, RET_V_W, ATT_Q_W, ATT_KV_W, ATT_KV_W,
            CONV_DIM, CONV_DIM, CONV_DIM, D_MODEL, D_MODEL, D_MODEL)
IN_COLS = sum(IN_SIZES)

kernel_name = "hybrid_prefix_diffusion_trunk_step"


def rms_norm(x, g):
    xf = x.astype(jnp.float32)
    y = xf * lax.rsqrt(jnp.mean(xf * xf, axis=-1, keepdims=True) + EPS)
    return (y * g.astype(jnp.float32)).astype(x.dtype)


def modulate_norm(x, g, shift, scale):
    return rms_norm(x, g) * (1 + scale) + shift


def swiglu(x, w_in, w_out):
    gate, up = jnp.split(x @ w_in, 2, axis=-1)
    return (jax.nn.silu(gate) * up) @ w_out


def axial_rope_tables(n_tok):
    rows = n_tok // GRID_W
    t_row = jnp.repeat(jnp.arange(rows, dtype=jnp.float32), GRID_W)
    t_col = jnp.tile(jnp.arange(GRID_W, dtype=jnp.float32), rows)
    n_freq = HEAD_DIM // 4
    inv = ROPE_THETA ** (-jnp.arange(n_freq, dtype=jnp.float32) / n_freq)
    ang = jnp.concatenate([t_row[:, None] * inv, t_col[:, None] * inv], axis=-1)
    return jnp.cos(ang), jnp.sin(ang)


def apply_rope(x, cos, sin):
    half = HEAD_DIM // 2
    shape = (1, cos.shape[0]) + (1,) * (x.ndim - 3) + (half,)
    c = cos.reshape(shape)
    s = sin.reshape(shape)
    xf = x.astype(jnp.float32)
    x1, x2 = xf[..., :half], xf[..., half:]
    return jnp.concatenate([x1 * c - x2 * s, x1 * s + x2 * c], axis=-1).astype(x.dtype)


def retention_chunked(q, k, v, log_gamma, s0):
    B, T, H, _ = q.shape
    DV = v.shape[-1]
    n = T // RET_CHUNK

    def chunks(a):
        return a.astype(jnp.float32).reshape(B, n, RET_CHUNK, H, a.shape[-1]).transpose(1, 0, 3, 2, 4)

    qc, kc, vc = chunks(q), chunks(k), chunks(v)
    pos = jnp.arange(RET_CHUNK, dtype=jnp.float32)
    lg = log_gamma.astype(jnp.float32)[:, None]
    diff = pos[:, None] - pos[None, :]
    decay_in = jnp.where(diff >= 0, jnp.exp(lg[:, :, None] * jnp.maximum(diff, 0.0)), 0.0)
    decay_q = jnp.exp(lg * (pos + 1.0))[..., None]
    decay_k = jnp.exp(lg * (RET_CHUNK - 1.0 - pos))[..., None]
    decay_c = jnp.exp(lg * RET_CHUNK)[..., None]

    def step(s, inp):
        qi, ki, vi = inp
        att = jnp.einsum('bhcd,bhmd->bhcm', qi, ki) * decay_in
        o = jnp.einsum('bhcm,bhme->bhce', att, vi) + jnp.einsum('bhcd,bhde->bhce', qi, s) * decay_q
        s = s * decay_c + jnp.einsum('bhmd,bhme->bhde', ki * decay_k, vi)
        return s, o

    s_fin, o = lax.scan(step, s0.astype(jnp.float32), (qc, kc, vc))
    o = o.transpose(1, 0, 3, 2, 4).reshape(B, T, H, DV)
    return o, s_fin


def blocked_attention(q, k, v):
    B, T, KV, G, Dh = q.shape
    nb = T // Q_BLOCK
    qb = q.reshape(B, nb, Q_BLOCK, KV, G, Dh).swapaxes(0, 1)
    scale = Dh ** -0.5

    def one_block(q_blk):
        s = jnp.einsum('bqkgd,bskd->bkgqs', q_blk, k, preferred_element_type=jnp.float32) * scale
        p = jax.nn.softmax(s, axis=-1).astype(v.dtype)
        return jnp.einsum('bkgqs,bskd->bqkgd', p, v)

    o = lax.map(one_block, qb)
    return o.swapaxes(0, 1).reshape(B, T, KV, G, Dh)


def short_conv3(u, w):
    up = jnp.pad(u, ((0, 0), (1, 1), (0, 0)))
    return up[:, :-2] * w[0] + up[:, 1:-1] * w[1] + up[:, 2:] * w[2]


def token_mix(xn, w_in, decay_logit, ret_gn, q_gain, k_gain, conv_w, w_ret_o, w_att_o, w_conv_o, w_o,
              ret_s0, kv_prefix, rope):
    B, T, _ = xn.shape
    parts = jnp.split(xn @ w_in, np.cumsum(IN_SIZES)[:-1].tolist(), axis=-1)
    rq, rk, rv, rg, aq, ak, av, cb, cc, cx, g_ret, g_att, g_conv = parts

    rq = rq.reshape(B, T, N_RET_HEADS, RET_DK)
    rk = rk.reshape(B, T, N_RET_HEADS, RET_DK) * (RET_DK ** -0.5)
    rv = rv.reshape(B, T, N_RET_HEADS, RET_DV)
    log_gamma = jax.nn.log_sigmoid(decay_logit.astype(jnp.float32))
    o_f, s_f = retention_chunked(rq, rk, rv, log_gamma[0], ret_s0[:, 0])
    o_b, s_b = retention_chunked(rq[:, ::-1], rk[:, ::-1], rv[:, ::-1], log_gamma[1], ret_s0[:, 1])
    o_r = (o_f + o_b[:, ::-1]).astype(xn.dtype)
    o_r = rms_norm(o_r, ret_gn.reshape(N_RET_HEADS, RET_DV)).reshape(B, T, RET_V_W)
    y_ret = (jax.nn.silu(rg) * o_r) @ w_ret_o
    ret_state = jnp.stack([s_f, s_b], axis=1).astype(xn.dtype)

    q = rms_norm(aq.reshape(B, T, N_KV_HEADS, N_HEADS // N_KV_HEADS, HEAD_DIM), q_gain)
    k = rms_norm(ak.reshape(B, T, N_KV_HEADS, HEAD_DIM), k_gain)
    v = av.reshape(B, T, N_KV_HEADS, HEAD_DIM)
    if rope is None:
        k_all, v_all = k, v
    else:
        q = apply_rope(q, rope[0], rope[1])
        k_all = jnp.concatenate([kv_prefix[0], apply_rope(k, rope[0], rope[1])], axis=1)
        v_all = jnp.concatenate([kv_prefix[1], v], axis=1)
    y_att = blocked_attention(q, k_all, v_all).reshape(B, T, ATT_Q_W) @ w_att_o

    y_conv = (cb * short_conv3(cc * cx, conv_w)) @ w_conv_o

    merged = (jax.nn.sigmoid(g_ret) * y_ret + jax.nn.sigmoid(g_att) * y_att
              + jax.nn.sigmoid(g_conv) * y_conv)
    return merged @ w_o, ret_state, k, v


def layer(h, cond, W, l, ret_s0, kv_prefix, rope):
    (w_ada, b_ada, norm_w, w_ffn_in, w_ffn_out, w_in, ret_decay_logit, ret_gn, q_gain, k_gain,
     conv_w, w_ret_o, w_att_o, w_conv_o, w_o) = W
    mod = (jax.nn.silu(cond) @ w_ada[l] + b_ada[l])[:, None, :]
    sh1, sc1, g1, sh2, sc2, g2, sh3, sc3, g3 = jnp.split(mod, N_MOD, axis=-1)
    h = h + 0.5 * g1 * swiglu(modulate_norm(h, norm_w[l, 0], sh1, sc1), w_ffn_in[l, 0], w_ffn_out[l, 0])
    y, ret_state, k, v = token_mix(modulate_norm(h, norm_w[l, 1], sh2, sc2), w_in[l], ret_decay_logit[l],
                                   ret_gn[l], q_gain[l], k_gain[l], conv_w[l], w_ret_o[l], w_att_o[l],
                                   w_conv_o[l], w_o[l], ret_s0, kv_prefix, rope)
    h = h + g2 * y
    h = h + 0.5 * g3 * swiglu(modulate_norm(h, norm_w[l, 2], sh3, sc3), w_ffn_in[l, 1], w_ffn_out[l, 1])
    return h, ret_state, k, v


def setup_inputs(seed: int = 0) -> dict:
    key = jax.random.key(seed)
    ks = jax.random.split(key, 24)
    f32 = jnp.float32

    def nrm(k, shape, s=1.0):
        return jax.random.normal(k, shape, f32) * s

    base_logit = jnp.log(2.0 ** (5.0 + jnp.arange(N_RET_HEADS, dtype=f32)) - 1.0)
    return {
        "x_prompt": nrm(ks[0], (BATCH, SEQ, D_MODEL)),
        "x_sample": nrm(ks[1], (DEC_BATCH, DEC_SEQ, D_MODEL)),
        "c": nrm(ks[2], (DEC_BATCH, D_MODEL)),
        "state_ret": nrm(ks[3], (DEC_BATCH, DEPTH, 2, N_RET_HEADS, RET_DK, RET_DV), 0.5),
        "cache_k": nrm(ks[4], (DEC_BATCH, DEPTH, PAST_LEN, N_KV_HEADS, HEAD_DIM)),
        "cache_v": nrm(ks[5], (DEC_BATCH, DEPTH, PAST_LEN, N_KV_HEADS, HEAD_DIM)),
        "c_ctx": nrm(ks[6], (D_MODEL,)),
        "w_ada": nrm(ks[7], (DEPTH, D_MODEL, N_MOD * D_MODEL), D_MODEL ** -0.5),
        "b_ada": nrm(ks[8], (DEPTH, N_MOD * D_MODEL), 0.02),
        "norm_w": 1.0 + nrm(ks[9], (DEPTH, 3, D_MODEL), 0.02),
        "w_ffn_in": nrm(ks[10], (DEPTH, 2, D_MODEL, 2 * FFN_DIM), D_MODEL ** -0.5),
        "w_ffn_out": nrm(ks[11], (DEPTH, 2, FFN_DIM, D_MODEL), FFN_DIM ** -0.5),
        "w_in": nrm(ks[12], (DEPTH, D_MODEL, IN_COLS), D_MODEL ** -0.5),
        "ret_decay_logit": base_logit + nrm(ks[13], (DEPTH, 2, N_RET_HEADS), 0.1),
        "ret_gn": 1.0 + nrm(ks[14], (DEPTH, RET_V_W), 0.02),
        "q_gain": 1.0 + nrm(ks[15], (DEPTH, HEAD_DIM), 0.02),
        "k_gain": 1.0 + nrm(ks[16], (DEPTH, HEAD_DIM), 0.02),
        "conv_w": nrm(ks[17], (DEPTH, CONV_K, CONV_DIM), CONV_K ** -0.5),
        "w_ret_o": nrm(ks[18], (DEPTH, RET_V_W, D_MODEL), RET_V_W ** -0.5),
        "w_att_o": nrm(ks[19], (DEPTH, ATT_Q_W, D_MODEL), ATT_Q_W ** -0.5),
        "w_conv_o": nrm(ks[20], (DEPTH, CONV_DIM, D_MODEL), CONV_DIM ** -0.5),
        "w_o": nrm(ks[21], (DEPTH, D_MODEL, D_MODEL), D_MODEL ** -0.5),
    }


def reference(x_prompt, x_sample, c, state_ret, cache_k, cache_v, c_ctx, w_ada, b_ada, norm_w, w_ffn_in,
              w_ffn_out, w_in, ret_decay_logit, ret_gn, q_gain, k_gain, conv_w, w_ret_o, w_att_o, w_conv_o, w_o):
    W = (w_ada, b_ada, norm_w, w_ffn_in, w_ffn_out, w_in, ret_decay_logit, ret_gn, q_gain, k_gain,
         conv_w, w_ret_o, w_att_o, w_conv_o, w_o)

    h = x_prompt
    zero_state = jnp.zeros((x_prompt.shape[0], 2, N_RET_HEADS, RET_DK, RET_DV), jnp.float32)
    states, keys, values = [], [], []
    for l in range(DEPTH):
        h, st, k, v = layer(h, c_ctx[None, :], W, l, zero_state, None, None)
        states.append(st)
        keys.append(k)
        values.append(v)
    y_prompt = h
    new_state_ret = jnp.stack(states, axis=1)
    new_cache_k = jnp.stack(keys, axis=1)
    new_cache_v = jnp.stack(values, axis=1)

    rope = axial_rope_tables(x_sample.shape[1])
    h = x_sample
    for l in range(DEPTH):
        h, _, _, _ = layer(h, c, W, l, state_ret[:, l], (cache_k[:, l], cache_v[:, l]), rope)
    y_sample = h
    return (y_prompt, y_sample, new_state_ret, new_cache_k, new_cache_v)
```

```cpp
#include <hip/hip_runtime.h>
#include <cstdio>
#include <cstdint>

#ifndef EN_UP
#define EN_UP 1
#endif
#ifndef EN_DOWN
#define EN_DOWN 1
#endif
#ifndef EN_WIN
#define EN_WIN 1
#endif
#ifndef EN_SIG
#define EN_SIG 1
#endif
#ifndef EN_MERGE
#define EN_MERGE 1
#endif
#ifndef EN_MIX1
#define EN_MIX1 1
#endif
#ifndef EN_RET3
#define EN_RET3 1
#endif
#ifndef EN_ATTN
#define EN_ATTN 1
#endif
#ifndef EN_PRO
#define EN_PRO 1
#endif
#ifndef MK_MULTI_LAUNCH
#define MK_MULTI_LAUNCH 0
#endif

namespace pg8 {
#define PG8_LAS __attribute__((address_space(3)))
typedef unsigned short bf16_t;
typedef short bf16x8 __attribute__((ext_vector_type(8)));
typedef float f32x4 __attribute__((ext_vector_type(4)));
typedef unsigned u32x4 __attribute__((ext_vector_type(4)));
constexpr int BM = 256, BK = 64, HALF = 128, HTB = HALF * BK * 2, STAGE_BYTES = 8 * HTB, NXCD = 8, WGM = 8;

__host__ __device__ __forceinline__ int lds_byte(int r, int c) { const int st = (r >> 4) * 2 + (c >> 5), rr = r & 15, cc = c & 31, ob = rr * 64 + cc * 2; return st * 1024 + (ob ^ (((ob >> 9) & 1) << 5)); }
__host__ __device__ __forceinline__ void stage_rc(int b, int& R, int& C) { const int st = b / 1024, sb = b % 1024, swz = sb ^ (((sb >> 9) & 1) << 5); R = (st >> 1) * 16 + swz / 64; C = (st & 1) * 32 + (swz % 64) / 2; }
__host__ __device__ __forceinline__ int perm32(int rho) { const int n = rho >> 4, i = rho & 15; return 8 * (i >> 2) + 4 * n + (i & 3); }

struct Unit { int pm, pn; };
struct Gemm { const bf16_t* A; const bf16_t* Bt; int M, N, K; };

struct StaticOrder {
    int nM, nN, nwg, G, c;
    __host__ __device__ void init(int M, int N, int G_, int c_) { nM = M / BM; nN = N / BM; nwg = nM * nN; G = G_; c = c_; }
    __host__ __device__ bool next(int i, Unit& u) const {
        const long L = (long)i * G + c; if (L >= nwg) return false;
        int wgid = (int)L; { const int q = nwg / NXCD, r = nwg % NXCD, xcd = wgid % NXCD, off = wgid / NXCD; wgid = (xcd < r ? xcd * (q + 1) : r * (q + 1) + (xcd - r) * q) + off; }
        const int nig = WGM * nN, gid = wgid / nig, fm = gid * WGM, gsz = (nM - fm) < WGM ? (nM - fm) : WGM;
        u.pm = fm + ((wgid % nig) % gsz); u.pn = (wgid % nig) / gsz; return true;
    }
};

typedef float f32x2_t __attribute__((ext_vector_type(2))); typedef __bf16 bf16x2_t __attribute__((ext_vector_type(2)));
__device__ __forceinline__ unsigned cvt_pk_bf16(float lo, float hi) { f32x2_t v = {lo, hi}; bf16x2_t b = __builtin_convertvector(v, bf16x2_t); return __builtin_bit_cast(unsigned, b); }
__device__ __forceinline__ float sigmoid_f(float x) { return __builtin_amdgcn_rcpf(1.0f + __expf(-x)); }
__device__ __forceinline__ float silu_f(float x) { return x * sigmoid_f(x); }
__device__ __forceinline__ float bflo(unsigned w) { return __uint_as_float(w << 16); }
__device__ __forceinline__ float bfhi(unsigned w) { return __uint_as_float(w & 0xffff0000u); }

template <int ACT> struct EpiPair {
    static constexpr bool PERM = true;
    bf16_t* O; int ldo; int tile0;
    __device__ __forceinline__ void operator()(const f32x4 (&acc)[2][2][4][2], const Unit& u, int wr, int wc, int fr, int fq) const {
        const int row0 = u.pm * BM + wr * 64 + fr, col0 = (u.pn - tile0) * HALF + wc * 32 + 8 * fq;
#pragma unroll
        for (int ai = 0; ai < 2; ++ai)
#pragma unroll
            for (int m = 0; m < 4; ++m) {
                bf16_t* rowp = O + (size_t)(row0 + ai * HALF + m * 16) * ldo + col0;
                f32x4 g0 = acc[ai][0][m][0], g1 = acc[ai][0][m][1]; const f32x4 u0 = acc[ai][1][m][0], u1 = acc[ai][1][m][1];
                if (ACT == 1) {
#pragma unroll
                    for (int j = 0; j < 4; ++j) { g0[j] = silu_f(g0[j]); g1[j] = silu_f(g1[j]); }
                }
                g0 = g0 * u0; g1 = g1 * u1;
                u32x4 w; w.x = cvt_pk_bf16(g0[0], g0[1]); w.y = cvt_pk_bf16(g0[2], g0[3]); w.z = cvt_pk_bf16(g1[0], g1[1]); w.w = cvt_pk_bf16(g1[2], g1[3]);
                *(u32x4*)rowp = w;
            }
    }
};
struct EpiWin {
    static constexpr bool PERM = true;
    bf16_t* U;
    __device__ __forceinline__ void operator()(const f32x4 (&acc)[2][2][4][2], const Unit& u, int wr, int wc, int fr, int fq) const {
        const int pn = u.pn; const size_t MP = (size_t)16384 * 512;
        const int row0 = u.pm * BM + wr * 64 + fr;
        if (pn >= 13) {
            EpiPair<0> e{U + 5 * MP + (size_t)16384 * 256 + MP, 512, 13}; e(acc, u, wr, wc, fr, fq); return;
        }
        bf16_t* base; int ld = 512, ct;
        if (pn < 10) { base = U + (size_t)(pn >> 1) * MP; ct = (pn & 1) * 256; }
        else if (pn == 10) { base = U + 5 * MP; ld = 256; ct = 0; }
        else { base = U + 5 * MP + (size_t)16384 * 256; ct = (pn - 11) * 256; }
        const bool do_silu = (pn == 6 || pn == 7);
        const int col0 = ct + wc * 32 + 8 * fq;
#pragma unroll
        for (int ai = 0; ai < 2; ++ai)
#pragma unroll
            for (int m = 0; m < 4; ++m) {
                bf16_t* rowp = base + (size_t)(row0 + ai * HALF + m * 16) * ld + col0;
#pragma unroll
                for (int bj = 0; bj < 2; ++bj) {
                    f32x4 v0 = acc[ai][bj][m][0], v1 = acc[ai][bj][m][1];
                    if (do_silu) {
#pragma unroll
                        for (int j = 0; j < 4; ++j) { v0[j] = silu_f(v0[j]); v1[j] = silu_f(v1[j]); }
                    }
                    u32x4 w; w.x = cvt_pk_bf16(v0[0], v0[1]); w.y = cvt_pk_bf16(v0[2], v0[3]); w.z = cvt_pk_bf16(v1[0], v1[1]); w.w = cvt_pk_bf16(v1[2], v1[3]);
                    *(u32x4*)(rowp + bj * HALF) = w;
                }
            }
    }
};
struct EpiResid {
    static constexpr bool PERM = false;
    const float* base_lo; const float* base_hi; float* out; const float* gate; int gate_stride; float gs;
    __device__ __forceinline__ void operator()(const f32x4 (&acc)[2][2][4][2], const Unit& u, int wr, int wc, int fr, int fq) const {
        const int col0 = u.pn * BM + wc * 32 + 4 * fq;
        const int ci = u.pm < 32 ? 0 : (u.pm < 48 ? 1 : 2);
        const float* gp = gate + (size_t)ci * gate_stride + col0;
        f32x4 gv[2][2];
#pragma unroll
        for (int bj = 0; bj < 2; ++bj)
#pragma unroll
            for (int n = 0; n < 2; ++n) gv[bj][n] = *(const f32x4*)(gp + bj * HALF + n * 16) * gs;
        const float* bb = u.pm < 32 ? base_lo + (size_t)u.pm * BM * 1024 : base_hi + (size_t)(u.pm - 32) * BM * 1024;
        float* oo = out + (size_t)u.pm * BM * 1024;
#pragma unroll
        for (int ai = 0; ai < 2; ++ai)
#pragma unroll
            for (int m = 0; m < 4; ++m) {
                const size_t off = (size_t)(ai * HALF + wr * 64 + m * 16 + fr) * 1024 + col0;
#pragma unroll
                for (int bj = 0; bj < 2; ++bj)
#pragma unroll
                    for (int n = 0; n < 2; ++n) {
                        const f32x4 b = *(const f32x4*)(bb + off + bj * HALF + n * 16);
                        *(f32x4*)(oo + off + bj * HALF + n * 16) = b + gv[bj][n] * acc[ai][bj][m][n];
                    }
            }
    }
};
struct EpiSig {
    static constexpr bool PERM = true;
    bf16_t* GS; float* DBGT;
    __device__ __forceinline__ void operator()(const f32x4 (&acc)[2][2][4][2], const Unit& u, int wr, int wc, int fr, int fq) const {
        const int row0 = u.pm * BM + wr * 64 + fr, col0 = u.pn * BM + wc * 32 + 8 * fq;
        if (DBGT) { float* p = DBGT + (size_t)(row0 + HALF + 48) * 1024 + col0 + HALF; *(f32x4*)p = acc[1][1][3][0]; *(f32x4*)(p + 4) = acc[1][1][3][1]; }
#pragma unroll
        for (int ai = 0; ai < 2; ++ai)
#pragma unroll
            for (int m = 0; m < 4; ++m) {
                bf16_t* rowp = GS + (size_t)(row0 + ai * HALF + m * 16) * 1024 + col0;
#pragma unroll
                for (int bj = 0; bj < 2; ++bj) {
                    f32x4 v0 = acc[ai][bj][m][0], v1 = acc[ai][bj][m][1];
#pragma unroll
                    for (int j = 0; j < 4; ++j) { v0[j] = sigmoid_f(v0[j]); v1[j] = sigmoid_f(v1[j]); }
                    u32x4 w; w.x = cvt_pk_bf16(v0[0], v0[1]); w.y = cvt_pk_bf16(v0[2], v0[3]); w.z = cvt_pk_bf16(v1[0], v1[1]); w.w = cvt_pk_bf16(v1[2], v1[3]);
                    *(u32x4*)(rowp + bj * HALF) = w;
                }
            }
    }
};
struct EpiMerge {
    static constexpr bool PERM = true;
    const bf16_t* GS; float* T; bf16_t* MG; int mode;
    __device__ __forceinline__ void operator()(const f32x4 (&acc)[2][2][4][2], const Unit& u, int wr, int wc, int fr, int fq) const {
        const int row0 = u.pm * BM + wr * 64 + fr, col0 = u.pn * BM + wc * 32 + 8 * fq;
#pragma unroll
        for (int ai = 0; ai < 2; ++ai)
#pragma unroll
            for (int m = 0; m < 4; ++m) {
                const size_t ro = (size_t)(row0 + ai * HALF + m * 16) * 1024 + col0;
#pragma unroll
                for (int bj = 0; bj < 2; ++bj) {
                    const u32x4 g = *(const u32x4*)(GS + ro + bj * HALF);
                    f32x4 v0 = acc[ai][bj][m][0], v1 = acc[ai][bj][m][1];
                    v0[0] *= bflo(g.x); v0[1] *= bfhi(g.x); v0[2] *= bflo(g.y); v0[3] *= bfhi(g.y);
                    v1[0] *= bflo(g.z); v1[1] *= bfhi(g.z); v1[2] *= bflo(g.w); v1[3] *= bfhi(g.w);
                    float* tp = T + ro + bj * HALF;
                    if (mode != 0) { v0 = v0 + *(const f32x4*)tp; v1 = v1 + *(const f32x4*)(tp + 4); }
                    if (mode != 2) { *(f32x4*)tp = v0; *(f32x4*)(tp + 4) = v1; }
                    else { u32x4 w; w.x = cvt_pk_bf16(v0[0], v0[1]); w.y = cvt_pk_bf16(v0[2], v0[3]); w.z = cvt_pk_bf16(v1[0], v1[1]); w.w = cvt_pk_bf16(v1[2], v1[3]);
                           *(u32x4*)(MG + ro + bj * HALF) = w; }
                }
            }
    }
};

template <class Epi, class Sched>
__device__ __forceinline__ void gemm_phase(PG8_LAS unsigned char* lds, const Gemm g, const Sched& S, const Epi& E, const int tid) {
    const int wid = __builtin_amdgcn_readfirstlane(tid >> 6), lane = tid & 63, wr = wid >> 2, wc = wid & 3, fr = lane & 15, fq = lane >> 4;
    const int K = g.K, nt = K / BK;
    unsigned voffA[2], voffB[2];
#pragma unroll
    for (int i = 0; i < 2; ++i) { int R, C; stage_rc(tid * 16 + i * 8192, R, C); const int Rb = Epi::PERM ? ((R & ~31) + perm32(R & 31)) : R;
        voffA[i] = (unsigned)(R * K + C) * 2u; voffB[i] = (unsigned)(Rb * K + C) * 2u; }
    const size_t kstep = (size_t)(BK * 2);
    const size_t hstep = (size_t)HALF * K * 2;
    const size_t tstep = 2 * hstep;
    const unsigned ldsw = (unsigned)wid * 1024u;
    const int aoff = lds_byte(wr * 64 + fr, fq * 8), boff = lds_byte(wc * 32 + fr, fq * 8);
#define PG8_SA(b, h) (((b) * 2 + (h)) * HTB)
#define PG8_SB(b, h) ((4 + (b) * 2 + (h)) * HTB)
#define PG8_STAGE(bufoff, gbase, voff) do { _Pragma("unroll") for (int _i = 0; _i < 2; ++_i) \
        __builtin_amdgcn_global_load_lds((const unsigned*)((const char*)(gbase) + (voff)[_i]), (PG8_LAS unsigned*)(lds + (bufoff) + ldsw + _i * 8192), 16, 0, 0); } while (0)
#define PG8_LDA(dst, b, h) do { _Pragma("unroll") for (int m = 0; m < 4; ++m) _Pragma("unroll") for (int k = 0; k < 2; ++k) dst[m][k] = *(const PG8_LAS bf16x8*)(lds + PG8_SA(b, h) + aoff + m * 2048 + k * 1024); } while (0)
#define PG8_LDB(dst, b, h) do { _Pragma("unroll") for (int n = 0; n < 2; ++n) _Pragma("unroll") for (int k = 0; k < 2; ++k) dst[n][k] = *(const PG8_LAS bf16x8*)(lds + PG8_SB(b, h) + boff + n * 2048 + k * 1024); } while (0)
#define PG8_MMA(ai, bj, At, Bt) do { __builtin_amdgcn_s_setprio(1); _Pragma("unroll") for (int m = 0; m < 4; ++m) _Pragma("unroll") for (int n = 0; n < 2; ++n) _Pragma("unroll") for (int k = 0; k < 2; ++k) \
        acc[ai][bj][m][n] = __builtin_amdgcn_mfma_f32_16x16x32_bf16(Bt[n][k], At[m][k], acc[ai][bj][m][n], 0, 0, 0); __builtin_amdgcn_s_setprio(0); } while (0)
#define PG8_WAIT_V(n) asm volatile("s_waitcnt vmcnt(" #n ")" ::: "memory")
#define PG8_WAIT_L(n) asm volatile("s_waitcnt lgkmcnt(" #n ")" ::: "memory")
#define PG8_BAR __builtin_amdgcn_s_barrier()
#define PG8_SCHED __builtin_amdgcn_sched_barrier(0)
    Unit cur, nxt; int ui = 0;
    if (!S.next(0, cur)) return;
    f32x4 acc[2][2][4][2];
#pragma unroll
    for (int a = 0; a < 2; ++a)
#pragma unroll
        for (int b = 0; b < 2; ++b)
#pragma unroll
            for (int m = 0; m < 4; ++m)
#pragma unroll
                for (int n = 0; n < 2; ++n) acc[a][b][m][n] = (f32x4){0.f, 0.f, 0.f, 0.f};
    bf16x8 At[4][2], B0[2][2], B1[2][2];
    const char* cA = (const char*)g.A + (size_t)cur.pm * tstep; const char* cB = (const char*)g.Bt + (size_t)cur.pn * tstep;
    PG8_STAGE(PG8_SB(0, 0), cB, voffB); PG8_STAGE(PG8_SB(0, 1), cB + hstep, voffB); PG8_STAGE(PG8_SA(0, 0), cA, voffA); PG8_STAGE(PG8_SA(0, 1), cA + hstep, voffA);
    if (wr == 1) PG8_BAR;
    PG8_WAIT_V(2); PG8_BAR;
    PG8_STAGE(PG8_SB(1, 0), cB + kstep, voffB); PG8_STAGE(PG8_SA(1, 0), cA + kstep, voffA); PG8_STAGE(PG8_SB(1, 1), cB + hstep + kstep, voffB);
    PG8_WAIT_V(6); PG8_BAR;
    for (;;) {
        const bool has_next = S.next(ui + 1, nxt);
        const char* nA = has_next ? (const char*)g.A + (size_t)nxt.pm * tstep : cA; const char* nB = has_next ? (const char*)g.Bt + (size_t)nxt.pn * tstep : cB;
        for (int t = 0; t < nt; t += 2) {
            const bool last = (t == nt - 2);
            const char* a1 = cA + (size_t)(t + 1) * kstep;
            const char* a2 = last ? nA : cA + (size_t)(t + 2) * kstep; const char* b2 = last ? nB : cB + (size_t)(t + 2) * kstep;
            const char* a3 = a2 + kstep; const char* b3 = b2 + kstep;
            PG8_LDB(B0, 0, 0); PG8_LDB(B1, 0, 1); PG8_SCHED; PG8_LDA(At, 0, 0); PG8_STAGE(PG8_SA(1, 1), a1 + hstep, voffA);
            PG8_WAIT_V(8); PG8_WAIT_L(0); PG8_BAR; PG8_MMA(0, 0, At, B0); PG8_MMA(0, 1, At, B1); PG8_BAR; PG8_SCHED;
            PG8_LDA(At, 0, 1); PG8_STAGE(PG8_SB(0, 0), b2, voffB); PG8_STAGE(PG8_SB(0, 1), b2 + hstep, voffB); PG8_STAGE(PG8_SA(0, 0), a2, voffA);
            PG8_WAIT_V(8); PG8_WAIT_L(0); PG8_BAR; PG8_MMA(1, 0, At, B0); PG8_MMA(1, 1, At, B1); PG8_BAR; PG8_SCHED;
            PG8_LDB(B0, 1, 0); PG8_LDB(B1, 1, 1); PG8_SCHED; PG8_LDA(At, 1, 0); PG8_STAGE(PG8_SA(0, 1), a2 + hstep, voffA);
            PG8_WAIT_V(8); PG8_WAIT_L(0); PG8_BAR; PG8_MMA(0, 0, At, B0); PG8_MMA(0, 1, At, B1); PG8_BAR; PG8_SCHED;
            PG8_LDA(At, 1, 1); PG8_STAGE(PG8_SB(1, 0), b3, voffB); PG8_STAGE(PG8_SB(1, 1), b3 + hstep, voffB); PG8_STAGE(PG8_SA(1, 0), a3, voffA);
            PG8_WAIT_V(8); PG8_WAIT_L(0); PG8_BAR; PG8_MMA(1, 0, At, B0); PG8_MMA(1, 1, At, B1); PG8_BAR; PG8_SCHED;
        }
        if (wr == 0) PG8_BAR;
        E(acc, cur, wr, wc, fr, fq);
        if (!has_next) break;
#pragma unroll
        for (int a = 0; a < 2; ++a)
#pragma unroll
            for (int b = 0; b < 2; ++b)
#pragma unroll
                for (int m = 0; m < 4; ++m)
#pragma unroll
                    for (int n = 0; n < 2; ++n) acc[a][b][m][n] = (f32x4){0.f, 0.f, 0.f, 0.f};
        cur = nxt; cA = nA; cB = nB; ++ui;
        if (wr == 1) PG8_BAR;
    }
    PG8_WAIT_V(0);
    PG8_BAR;
#undef PG8_SA
#undef PG8_SB
#undef PG8_STAGE
#undef PG8_LDA
#undef PG8_LDB
#undef PG8_MMA
#undef PG8_WAIT_V
#undef PG8_WAIT_L
#undef PG8_BAR
#undef PG8_SCHED
}
}

constexpr int NWAVES = 8;
constexpr int DM = 1024, MTOK = 16384, MCTX = 8192, FFN = 2816, NFF1 = 5632, NINM = 4352, NGATE = 3072, NIN_SRC = 7424;
constexpr int DEPTH = 2, SEQC = 256, SEQL = 4096, PAST = 512, SKL = PAST + SEQL;
constexpr float EPS = 1e-6f;
constexpr int OUT_STATE = 16777216, OUT_CK = 25165824, OUT_CV = 27262976, OUT_TOTAL = 29360128;

constexpr size_t MiB = 1u << 20;
constexpr size_t WS_CTL = 0, CTL_ZERO_BYTES = 1 * MiB;
constexpr size_t WS_MOD = 1 * MiB;
constexpr size_t WS_ROPE = WS_MOD + 256 * 1024;
constexpr size_t WS_WFF1 = 2 * MiB;
constexpr size_t WS_WFF2 = 24 * MiB;
constexpr size_t WS_WINM = 35 * MiB;
constexpr size_t WS_WG = WS_WINM + 8 * MiB + 512 * 1024;
constexpr size_t WS_WRO = WS_WG + 6 * MiB;
constexpr size_t WS_WO = WS_WRO + 3 * MiB;
constexpr size_t WS_KL = 55 * MiB;
constexpr size_t WS_VL = WS_KL + 4 * MiB + 512 * 1024;
constexpr size_t WS_KC = WS_VL + 4 * MiB + 512 * 1024;
constexpr size_t WS_VC = WS_KC + 2 * MiB;
constexpr size_t WS_XN = 68 * MiB;
constexpr size_t WS_R1 = 100 * MiB;
constexpr size_t WS_GS = 220 * MiB;
constexpr size_t WS_T = 252 * MiB;
constexpr size_t WS_END = 316 * MiB;
constexpr size_t PLANE = (size_t)MTOK * 512;
constexpr size_t U_RQ = 0, U_RK = PLANE, U_RV = 2 * PLANE, U_SRG = 3 * PLANE, U_AQ = 4 * PLANE, U_AKV = 5 * PLANE, U_CB = 5 * PLANE + (size_t)MTOK * 256, U_P = U_CB + PLANE;
constexpr size_t U_MG = U_RK;
constexpr int CW_BAR = 4096;

constexpr int RING_BYTES = 131072, MISC_OFF = RING_BYTES + 320, LDS_BYTES = 147456;

#define GAS __attribute__((address_space(1)))
#define LAS __attribute__((address_space(3)))
typedef unsigned short bf16;
typedef unsigned v4u __attribute__((ext_vector_type(4)));
typedef float f32x4 __attribute__((ext_vector_type(4)));
#define RLX_AGENT __ATOMIC_RELAXED, __HIP_MEMORY_SCOPE_AGENT
__device__ __forceinline__ unsigned f2bf(float f) { unsigned u = __builtin_bit_cast(unsigned, f); return (u + 0x7fffu + ((u >> 16) & 1u)) >> 16; }
__device__ __forceinline__ unsigned pk2(float lo, float hi) { return f2bf(lo) | (f2bf(hi) << 16); }
__device__ __forceinline__ float bf2f(unsigned short h) { return __uint_as_float(((unsigned)h) << 16); }
__device__ __forceinline__ float blo(unsigned w) { return __uint_as_float(w << 16); }
__device__ __forceinline__ float bhi(unsigned w) { return __uint_as_float(w & 0xffff0000u); }
__device__ __forceinline__ float fexp2(float x) { return __builtin_amdgcn_exp2f(x); }
__device__ __forceinline__ float fexp(float x) { return __builtin_amdgcn_exp2f(x * 1.4426950408889634f); }
__device__ __forceinline__ float frsq(float x) { return __builtin_amdgcn_rsqf(x); }

#define XB_TMO      128
#define XB_XCNT(j)  (256  + 64 * (j))
#define XB_XSUB(j)  (1280 + 64 * (j))
#define XB_XGEN(j)  (2304 + 64 * (j))
#define XB_TOP      3328
#define XB_TOPGEN   3392
#define XCD_BAR_WORDS 3456
#define XB_SPIN_CAP (1u << 18)
__device__ __forceinline__ unsigned xb_ld(unsigned* p)              { return __hip_atomic_load(p, __ATOMIC_RELAXED, __HIP_MEMORY_SCOPE_AGENT); }
__device__ __forceinline__ unsigned xb_add(unsigned* p, unsigned v) { return __hip_atomic_fetch_add(p, v, __ATOMIC_RELAXED, __HIP_MEMORY_SCOPE_AGENT); }
__device__ __forceinline__ unsigned xb_xcc_id() { return (unsigned)__builtin_amdgcn_s_getreg((3 << 11) | 20) & 0xFu; }
#define XB_SPIN(cond, bar) do { unsigned _sp = 0; while (cond) { __builtin_amdgcn_s_sleep(1); \
    if ((++_sp & 255u) == 0u) { if (xb_ld(&(bar)[XB_TMO])) break; if (_sp > XB_SPIN_CAP) { atomicAdd(&(bar)[XB_TMO], 1u); break; } } } } while (0)
struct XcdBarrier { unsigned* bar; unsigned x; volatile LAS unsigned* st; };
__device__ __forceinline__ XcdBarrier xcd_barrier_post(unsigned* bar, volatile LAS unsigned* st) {
    XcdBarrier b; b.bar = bar; b.x = xb_xcc_id(); b.st = st;
    if (threadIdx.x == 0) (void)xb_add(&bar[XB_XCNT(b.x)], 1u);
    return b;
}
__device__ __forceinline__ void xcd_barrier_complete(unsigned* bar, unsigned x, unsigned& nloc, unsigned& nx) {
    const unsigned G = gridDim.x * gridDim.y * gridDim.z;
    unsigned sum, cnt, mine, sp = 0u;
    for (;;) {
        sum = 0u; cnt = 0u; mine = 0u;
#pragma unroll
        for (unsigned j = 0; j < 16; ++j) { const unsigned c = xb_ld(&bar[XB_XCNT(j)]); sum += c; cnt += (c > 0u) ? 1u : 0u; mine = (j == x) ? c : mine; }
        if (sum == G) break;
        __builtin_amdgcn_s_sleep(1);
        if ((++sp & 255u) == 0u) { if (xb_ld(&bar[XB_TMO])) break; if (sp > XB_SPIN_CAP) { atomicAdd(&bar[XB_TMO], 1u); break; } }
    }
    nloc = mine > 0u ? mine : 1u; nx = cnt > 0u ? cnt : 1u;
}
__device__ __forceinline__ void xcd_barrier(const XcdBarrier& b, const int tid) {
    asm volatile("s_waitcnt vmcnt(0)" ::: "memory");
    __syncthreads();
    if (tid == 0) {
        unsigned* bar = b.bar;
        __builtin_amdgcn_s_waitcnt(0);
        unsigned nloc = b.st[0], nx = b.st[1];
        if (nloc == 0u) { xcd_barrier_complete(bar, b.x, nloc, nx); b.st[0] = nloc; b.st[1] = nx; }
        const unsigned old = xb_add(&bar[XB_XSUB(b.x)], 1u);
        const unsigned gen = old / nloc;
        if (old + 1u == (gen + 1u) * nloc) {
            __builtin_amdgcn_fence(__ATOMIC_RELEASE, "agent");
            asm volatile("s_waitcnt vmcnt(0)" ::: "memory");
            const unsigned og = xb_add(&bar[XB_TOP], 1u);
            const unsigned tg = og / nx;
            if (og + 1u == (tg + 1u) * nx) xb_add(&bar[XB_TOPGEN], 1u);
            else XB_SPIN(xb_ld(&bar[XB_TOPGEN]) == tg, bar);
            __builtin_amdgcn_fence(__ATOMIC_ACQUIRE, "agent");
            xb_add(&bar[XB_XGEN(b.x)], 1u);
            asm volatile("s_waitcnt vmcnt(0)" ::: "memory");
        } else {
            XB_SPIN(xb_ld(&bar[XB_XGEN(b.x)]) == gen, bar);
            __builtin_amdgcn_fence(__ATOMIC_ACQUIRE, "agent");
            asm volatile("s_waitcnt vmcnt(0)" ::: "memory");
        }
    }
    __syncthreads();
}

struct Args { const float* in[22]; float* out; unsigned char* ws; int ph_lo, ph_hi; };
enum { I_XP = 0, I_XS, I_C, I_STATE, I_CK, I_CV, I_CCTX, I_WADA, I_BADA, I_NORMW, I_WFFIN, I_WFFOUT, I_WIN, I_DECAY, I_RETGN, I_QG, I_KG, I_CONVW, I_WRO, I_WAO, I_WCO, I_WO };

typedef const Args __attribute__((address_space(4))) CArgs;
__device__ __forceinline__ CArgs* get_args() { CArgs* p = (CArgs*)__builtin_amdgcn_kernarg_segment_ptr(); asm volatile("" : "+s"(p)); return p; }
struct Frame {
    LAS unsigned char* lds;
    int tid, lane, wave, vcu, G, bx;
};
__device__ __forceinline__ int cond_of_row(int m) { return m < MCTX ? 0 : (m < MCTX + SEQL ? 1 : 2); }
__device__ __forceinline__ float wave_sum(float v) {
#pragma unroll
    for (int o = 1; o < 64; o <<= 1) v += __shfl_xor(v, o);
    return v;
}

__device__ __forceinline__ void transpose_item(const float* W, int K, int srcN, int src_col0, bf16* WT, int dst_row0, int k0, LAS float* scr, int lane) {
#pragma unroll 8
    for (int i = 0; i < 32; ++i) { const int kk = 2 * i + (lane >> 5); scr[kk * 33 + (lane & 31)] = W[(size_t)(k0 + kk) * srcN + src_col0 + (lane & 31)]; }
    asm volatile("s_waitcnt lgkmcnt(0)" ::: "memory");
    const int c = lane & 7;
#pragma unroll
    for (int j = 0; j < 4; ++j) { const int n = (lane >> 3) + 8 * j; const LAS float* s = scr + (8 * c) * 33 + n;
        v4u o; o.x = pk2(s[0 * 33], s[1 * 33]); o.y = pk2(s[2 * 33], s[3 * 33]); o.z = pk2(s[4 * 33], s[5 * 33]); o.w = pk2(s[6 * 33], s[7 * 33]);
        *(GAS v4u*)(WT + (size_t)(dst_row0 + n) * K + k0 + 8 * c) = o; }
    asm volatile("s_waitcnt lgkmcnt(0)" ::: "memory");
}
__device__ __forceinline__ void convert_weights(Frame& F, int l) {
    LAS float* scr = (LAS float*)(F.lds + F.wave * 16384);
    const int gw = F.vcu * NWAVES + F.wave, NGW = F.G * NWAVES;
    CArgs& A = *get_args(); unsigned char* const WSP = A.ws;
    constexpr int I_FF1 = 16 * 176, I_FF2 = 44 * 32, I_INM = 16 * 136, I_GT = 16 * 96, I_BO = 8 * 32, I_OO = 16 * 32;
    constexpr int NITEMS = 2 * I_FF1 + 2 * I_FF2 + I_INM + I_GT + 3 * I_BO + I_OO;
    for (int it = gw; it < NITEMS; it += NGW) {
        int r = it;
        if (r < 2 * I_FF1) {
            const int f = r / I_FF1; r -= f * I_FF1; const int kb = r / 176, nb = r % 176, t = nb >> 3, q = nb & 7;
            const int sc = (q < 4) ? (128 * t + 32 * q) : (FFN + 128 * t + 32 * (q - 4));
            transpose_item(A.in[I_WFFIN] + (size_t)(l * 2 + f) * DM * NFF1, DM, NFF1, sc, (bf16*)(WSP + WS_WFF1) + (size_t)f * NFF1 * DM, 32 * nb, 64 * kb, scr, F.lane); continue; }
        r -= 2 * I_FF1;
        if (r < 2 * I_FF2) { const int f = r / I_FF2; r -= f * I_FF2; const int kb = r / 32, nb = r % 32;
            transpose_item(A.in[I_WFFOUT] + (size_t)(l * 2 + f) * FFN * DM, FFN, DM, 32 * nb, (bf16*)(WSP + WS_WFF2) + (size_t)f * DM * FFN, 32 * nb, 64 * kb, scr, F.lane); continue; }
        r -= 2 * I_FF2;
        if (r < I_INM) { const int kb = r / 136, nb = r % 136, t = nb >> 3, q = nb & 7;
            int sc; if (t < 13) sc = 32 * nb; else { const int i = t - 13; sc = (q < 4) ? (3328 + 128 * i + 32 * q) : (3840 + 128 * i + 32 * (q - 4)); }
            transpose_item(A.in[I_WIN] + (size_t)l * DM * NIN_SRC, DM, NIN_SRC, sc, (bf16*)(WSP + WS_WINM), 32 * nb, 64 * kb, scr, F.lane); continue; }
        r -= I_INM;
        if (r < I_GT) { const int kb = r / 96, nb = r % 96;
            transpose_item(A.in[I_WIN] + (size_t)l * DM * NIN_SRC, DM, NIN_SRC, NINM + 32 * nb, (bf16*)(WSP + WS_WG), 32 * nb, 64 * kb, scr, F.lane); continue; }
        r -= I_GT;
        if (r < 3 * I_BO) { const int b = r / I_BO; r -= b * I_BO; const int kb = r / 32, nb = r % 32;
            const float* src = (b == 0 ? A.in[I_WRO] : (b == 1 ? A.in[I_WAO] : A.in[I_WCO])) + (size_t)l * 512 * DM;
            transpose_item(src, 512, DM, 32 * nb, (bf16*)(WSP + WS_WRO) + (size_t)b * DM * 512, 32 * nb, 64 * kb, scr, F.lane); continue; }
        r -= 3 * I_BO;
        { const int kb = r / 32, nb = r % 32;
          transpose_item(A.in[I_WO] + (size_t)l * DM * DM, DM, DM, 32 * nb, (bf16*)(WSP + WS_WO), 32 * nb, 64 * kb, scr, F.lane); }
    }
}
__device__ __forceinline__ void compute_mod(Frame& F) {
    CArgs& A = *get_args(); unsigned char* const WSP = A.ws;
    LAS float* sc = (LAS float*)(F.lds);
    LAS float* red = sc + 3072;
    for (int i = F.tid; i < 3072; i += 512) { const int ci = i >> 10, k = i & 1023; const float c = (ci == 0) ? A.in[I_CCTX][k] : A.in[I_C][(ci - 1) * 1024 + k]; sc[i] = c * __builtin_amdgcn_rcpf(1.0f + fexp(-c)); }
    __syncthreads();
    float* mod = (float*)(WSP + WS_MOD);
    for (int item = F.bx; item < 288; item += F.G) {
        const int l = item / 144, n0 = (item % 144) * 64, col = F.tid & 63, kg = F.tid >> 6;
        const float* w = A.in[I_WADA] + (size_t)l * DM * 9216 + n0 + col;
        float a0 = 0.f, a1 = 0.f, a2 = 0.f;
#pragma unroll 8
        for (int kk = 0; kk < 128; ++kk) { const int k = kg * 128 + kk; const float wv = w[(size_t)k * 9216]; a0 += sc[k] * wv; a1 += sc[1024 + k] * wv; a2 += sc[2048 + k] * wv; }
        red[(kg * 3 + 0) * 64 + col] = a0; red[(kg * 3 + 1) * 64 + col] = a1; red[(kg * 3 + 2) * 64 + col] = a2;
        __syncthreads();
        if (F.tid < 192) { const int ci = F.tid >> 6, c = F.tid & 63; float s = A.in[I_BADA][l * 9216 + n0 + c];
#pragma unroll
            for (int g = 0; g < 8; ++g) s += red[(g * 3 + ci) * 64 + c];
            mod[(size_t)(ci * 2 + l) * 9216 + n0 + c] = s; }
        __syncthreads();
    }
}
__device__ __forceinline__ void prologue_misc(Frame& F) {
    CArgs& A = *get_args(); unsigned char* const WSP = A.ws;
    if (F.bx == F.G - 1) {
        float* ct = (float*)(WSP + WS_ROPE); float* st = ct + 1024;
        for (int i = F.tid; i < 1024; i += 512) { const int pos = i >> 4, fi = i & 15; const float inv = fexp2(-(float)fi * 0.8304820237218406f);
            const float rev = (float)pos * inv * 0.15915494309189535f; ct[i] = __builtin_amdgcn_cosf(rev); st[i] = __builtin_amdgcn_sinf(rev); }
    }
    const int gt = F.bx * 512 + F.tid, NT = F.G * 512;
    bf16* KL = (bf16*)(WSP + WS_KL); bf16* VL = (bf16*)(WSP + WS_VL);
    for (int i = gt; i < 2 * 2 * PAST * 128; i += NT) {
        const int d = i & 63, kv = (i >> 6) & 1, s = (i >> 7) & 511, l = (i >> 16) & 1, b = i >> 17;
        const size_t dst = ((size_t)((l * 2 + b) * 2 + kv) * SKL + s) * 64 + d;
        KL[dst] = (bf16)f2bf(A.in[I_CK][i]); VL[dst] = (bf16)f2bf(A.in[I_CV][i]);
    }
}
__device__ __forceinline__ void modnorm_rows(Frame& F, int l, int j, bool from_x) {
    CArgs& A = *get_args(); unsigned char* const WSP = A.ws;
    const int gw = F.vcu * NWAVES + F.wave, NGW = F.G * NWAVES;
    const float* mod = (const float*)(WSP + WS_MOD);
    bf16* XN = (bf16*)(WSP + WS_XN);
    const float* nw = A.in[I_NORMW] + (size_t)(l * 3 + j) * DM;
    for (int m = gw; m < MTOK; m += NGW) {
        const float* xrow = from_x ? (m < MCTX ? A.in[I_XP] + (size_t)m * DM : A.in[I_XS] + (size_t)(m - MCTX) * DM) : A.out + (size_t)m * DM;
        const int ci = cond_of_row(m);
        const float* sh = mod + (size_t)(ci * 2 + l) * 9216 + (3 * j) * 1024; const float* scl = sh + 1024;
        const f32x4* xr = (const f32x4*)xrow + F.lane;
        f32x4 v[4]; float s2 = 0.f;
#pragma unroll
        for (int q = 0; q < 4; ++q) { v[q] = xr[64 * q]; s2 += (v[q].x * v[q].x + v[q].y * v[q].y) + (v[q].z * v[q].z + v[q].w * v[q].w); }
        const float rstd = frsq(wave_sum(s2) * (1.0f / DM) + EPS);
        unsigned long long* o8 = (unsigned long long*)(XN + (size_t)m * DM) + F.lane;
#pragma unroll
        for (int q = 0; q < 4; ++q) {
            const f32x4 g = ((const f32x4*)nw)[F.lane + 64 * q], s = ((const f32x4*)scl)[F.lane + 64 * q], b = ((const f32x4*)sh)[F.lane + 64 * q];
            const f32x4 y = v[q] * rstd * g * (s + 1.0f) + b;
            o8[64 * q] = (unsigned long long)pk2(y.x, y.y) | ((unsigned long long)pk2(y.z, y.w) << 32);
        }
    }
}
__device__ __forceinline__ void qk_pass(Frame& F, int l) {
    CArgs& A = *get_args(); unsigned char* const WSP = A.ws;
    const int gw = F.vcu * NWAVES + F.wave, NGW = F.G * NWAVES, lane = F.lane;
    bf16* U = (bf16*)(WSP + WS_R1);
    const float* ct = (const float*)(WSP + WS_ROPE); const float* st = ct + 1024;
    const float* qg = A.in[I_QG] + l * 64; const float* kg = A.in[I_KG] + l * 64;
    const int d0 = (lane & 7) * 8;
    const float QS = 0.125f * 1.4426950408889634f;
    for (int m = gw; m < MTOK; m += NGW) {
        const bool lat = m >= MCTX; int trow = 0, tcol = 0;
        if (lat) { const int t = (m - MCTX) & (SEQL - 1); trow = t >> 6; tcol = t & 63; }
        float cs[8], sn[8];
#pragma unroll
        for (int e = 0; e < 8; ++e) { const int i = (d0 & 31) + e; const int idx = (i < 16) ? (trow * 16 + i) : (tcol * 16 + (i - 16)); cs[e] = ct[idx]; sn[e] = st[idx]; }
        {
            bf16* qp = U + U_AQ + (size_t)m * 512 + lane * 8;
            const v4u w = *(const v4u*)qp;
            float x[8] = {blo(w.x), bhi(w.x), blo(w.y), bhi(w.y), blo(w.z), bhi(w.z), blo(w.w), bhi(w.w)};
            float ss = 0.f;
#pragma unroll
            for (int e = 0; e < 8; ++e) ss += x[e] * x[e];
            ss += __shfl_xor(ss, 1); ss += __shfl_xor(ss, 2); ss += __shfl_xor(ss, 4);
            const float r = frsq(ss * (1.0f / 64.0f) + EPS);
#pragma unroll
            for (int e = 0; e < 8; ++e) x[e] = x[e] * r * qg[d0 + e];
            if (lat) {
#pragma unroll
                for (int e = 0; e < 8; ++e) { const float p = __shfl_xor(x[e], 4); x[e] = (d0 < 32) ? (x[e] * cs[e] - p * sn[e]) : (p * sn[e] + x[e] * cs[e]); }
            }
            v4u o; o.x = pk2(x[0] * QS, x[1] * QS); o.y = pk2(x[2] * QS, x[3] * QS); o.z = pk2(x[4] * QS, x[5] * QS); o.w = pk2(x[6] * QS, x[7] * QS);
            *(v4u*)qp = o;
        }
        {
            const int l2 = lane & 31;
            const v4u w = *(const v4u*)(U + U_AKV + (size_t)m * 256 + l2 * 8);
            float x[8] = {blo(w.x), bhi(w.x), blo(w.y), bhi(w.y), blo(w.z), bhi(w.z), blo(w.w), bhi(w.w)};
            const bool isk = l2 < 16;
            float ss = 0.f;
#pragma unroll
            for (int e = 0; e < 8; ++e) ss += x[e] * x[e];
            ss += __shfl_xor(ss, 1); ss += __shfl_xor(ss, 2); ss += __shfl_xor(ss, 4);
            const float r = frsq(ss * (1.0f / 64.0f) + EPS);
            if (isk) {
#pragma unroll
                for (int e = 0; e < 8; ++e) x[e] = x[e] * r * kg[d0 + e];
            }
            const int kv = (l2 >> 3) & 1;
            if (!lat) {
                const int b = m >> 8, t = m & 255;
                if (lane < 32) {
                    float* dst = A.out + (isk ? OUT_CK : OUT_CV) + ((size_t)((b * 2 + l) * 256 + t) * 2 + kv) * 64 + d0;
                    *(f32x4*)dst = (f32x4){x[0], x[1], x[2], x[3]}; *(f32x4*)(dst + 4) = (f32x4){x[4], x[5], x[6], x[7]};
                    bf16* kc = (bf16*)(WSP + (isk ? WS_KC : WS_VC)) + ((size_t)(b * 2 + kv) * 256 + t) * 64 + d0;
                    v4u o; o.x = pk2(x[0], x[1]); o.y = pk2(x[2], x[3]); o.z = pk2(x[4], x[5]); o.w = pk2(x[6], x[7]);
                    *(v4u*)kc = o;
                }
            } else {
                float y[8];
#pragma unroll
                for (int e = 0; e < 8; ++e) { const float p = __shfl_xor(x[e], 4); y[e] = (d0 < 32) ? (x[e] * cs[e] - p * sn[e]) : (p * sn[e] + x[e] * cs[e]); }
                if (lane < 32) {
                    const int b = (m - MCTX) >> 12, t = (m - MCTX) & (SEQL - 1);
                    bf16* kc = (bf16*)(WSP + (isk ? WS_KL : WS_VL)) + ((size_t)((l * 2 + b) * 2 + kv) * SKL + PAST + t) * 64 + d0;
                    v4u o;
                    if (isk) { o.x = pk2(y[0], y[1]); o.y = pk2(y[2], y[3]); o.z = pk2(y[4], y[5]); o.w = pk2(y[6], y[7]); }
                    else { o.x = pk2(x[0], x[1]); o.y = pk2(x[2], x[3]); o.z = pk2(x[4], x[5]); o.w = pk2(x[6], x[7]); }
                    *(v4u*)kc = o;
                }
            }
        }
    }
}
__device__ __forceinline__ void conv_pass(Frame& F, int l) {
    CArgs& A = *get_args(); unsigned char* const WSP = A.ws;
    const int gw = F.vcu * NWAVES + F.wave, NGW = F.G * NWAVES, lane = F.lane;
    bf16* U = (bf16*)(WSP + WS_R1);
    const float* cw = A.in[I_CONVW] + (size_t)l * 3 * 512 + lane * 8;
    float w0[8], w1[8], w2[8];
#pragma unroll
    for (int e = 0; e < 8; ++e) { w0[e] = cw[e]; w1[e] = cw[512 + e]; w2[e] = cw[1024 + e]; }
    for (int m = gw; m < MTOK; m += NGW) {
        const int t = (m < MCTX) ? (m & 255) : ((m - MCTX) & (SEQL - 1)); const int T = (m < MCTX) ? SEQC : SEQL;
        const bf16* pp = U + U_P + (size_t)m * 512 + lane * 8;
        const v4u z = (v4u){0u, 0u, 0u, 0u};
        const v4u pc = *(const v4u*)pp, pm = (t > 0) ? *(const v4u*)(pp - 512) : z, pn = (t < T - 1) ? *(const v4u*)(pp + 512) : z;
        bf16* cbp = U + U_CB + (size_t)m * 512 + lane * 8;
        const v4u cb = *(const v4u*)cbp;
        float r[8];
        const unsigned pcw[4] = {pc.x, pc.y, pc.z, pc.w}, pmw[4] = {pm.x, pm.y, pm.z, pm.w}, pnw[4] = {pn.x, pn.y, pn.z, pn.w}, cbw[4] = {cb.x, cb.y, cb.z, cb.w};
#pragma unroll
        for (int q = 0; q < 4; ++q) {
            r[2 * q] = blo(cbw[q]) * (w0[2 * q] * blo(pmw[q]) + w1[2 * q] * blo(pcw[q]) + w2[2 * q] * blo(pnw[q]));
            r[2 * q + 1] = bhi(cbw[q]) * (w0[2 * q + 1] * bhi(pmw[q]) + w1[2 * q + 1] * bhi(pcw[q]) + w2[2 * q + 1] * bhi(pnw[q]));
        }
        v4u o; o.x = pk2(r[0], r[1]); o.y = pk2(r[2], r[3]); o.z = pk2(r[4], r[5]); o.w = pk2(r[6], r[7]);
        *(v4u*)cbp = o;
    }
}
__device__ __forceinline__ float log_gamma_of(CArgs& A, int l, int dir, int h) {
    const float x = A.in[I_DECAY][(l * 2 + dir) * 4 + h]; const float e = fexp(-x);
    const float ser = e * (1.0f - e * (0.5f - e * (0.33333334f - e * (0.25f - e * 0.2f))));
    const float big = __builtin_amdgcn_logf(1.0f + e) * 0.6931471805599453f;
    return -((e < 0.0625f) ? ser : big);
}
constexpr float RET_SCALE = 0.08838834764831845f;
__device__ __forceinline__ void ret_pass1(Frame& F, int l) {
    CArgs& A = *get_args(); unsigned char* const WSP = A.ws; const int tid = F.tid;
    bf16* U = (bf16*)(WSP + WS_R1);
    LAS bf16* Ks = (LAS bf16*)F.lds; LAS bf16* Vs = Ks + 128 * 128;
    float* LB = (float*)(WSP + WS_T);
    for (int unit = F.vcu; unit < 512; unit += F.G) {
        const int chunk = unit >> 2, h = unit & 3, m0 = chunk * 128;
        __syncthreads();
        for (int i = tid; i < 2048; i += 512) { const int j = i >> 4, c8 = (i & 15) * 8;
            *(LAS v4u*)(Ks + j * 128 + c8) = *(const v4u*)(U + U_RK + (size_t)(m0 + j) * 512 + h * 128 + c8);
            *(LAS v4u*)(Vs + j * 128 + c8) = *(const v4u*)(U + U_RV + (size_t)(m0 + j) * 512 + h * 128 + c8); }
        __syncthreads();
        const float lgf = log_gamma_of(A, l, 0, h), lgb = log_gamma_of(A, l, 1, h);
        const int d = tid >> 2, e0 = (tid & 3) * 32;
        float af[32], ab[32];
#pragma unroll
        for (int e = 0; e < 32; ++e) { af[e] = 0.f; ab[e] = 0.f; }
        for (int j = 0; j < 128; ++j) {
            const float kd = bf2f(Ks[j * 128 + d]) * RET_SCALE;
            const float kf = kd * fexp(lgf * (float)(127 - j)), kb = kd * fexp(lgb * (float)j);
#pragma unroll
            for (int q = 0; q < 4; ++q) { const v4u vv = *(const LAS v4u*)(Vs + j * 128 + e0 + q * 8);
                const float v8[8] = {blo(vv.x), bhi(vv.x), blo(vv.y), bhi(vv.y), blo(vv.z), bhi(vv.z), blo(vv.w), bhi(vv.w)};
#pragma unroll
                for (int e = 0; e < 8; ++e) { af[q * 8 + e] += kf * v8[e]; ab[q * 8 + e] += kb * v8[e]; } }
        }
        float* of = LB + ((size_t)(unit * 2 + 0) * 16384) + d * 128 + e0; float* ob = LB + ((size_t)(unit * 2 + 1) * 16384) + d * 128 + e0;
#pragma unroll
        for (int q = 0; q < 8; ++q) { *(f32x4*)(of + 4 * q) = (f32x4){af[4 * q], af[4 * q + 1], af[4 * q + 2], af[4 * q + 3]}; *(f32x4*)(ob + 4 * q) = (f32x4){ab[4 * q], ab[4 * q + 1], ab[4 * q + 2], ab[4 * q + 3]}; }
    }
}
__device__ __forceinline__ void ret_scan(Frame& F, int l) {
    CArgs& A = *get_args(); unsigned char* const WSP = A.ws;
    const float* LB = (const float*)(WSP + WS_T); float* SB = (float*)(WSP + WS_GS);
    const int gt = F.bx * 512 + F.tid, NT = F.G * 512;
    for (int i = gt; i < 65536; i += NT) {
        const int e4 = i & 4095, dir = (i >> 12) & 1, h = (i >> 13) & 3, b = i >> 15;
        const float g128 = fexp(128.0f * log_gamma_of(A, l, dir, h));
        f32x4 S = *(const f32x4*)(A.in[I_STATE] + ((size_t)(((b * 2 + l) * 2 + dir) * 4 + h) * 16384) + e4 * 4);
        for (int cc = 0; cc < 32; ++cc) {
            const int c = dir == 0 ? cc : 31 - cc; const int lc = b * 32 + c, chunk = 64 + lc;
            *(f32x4*)(SB + ((size_t)((lc * 4 + h) * 2 + dir) * 16384) + e4 * 4) = S;
            const f32x4 Lc = *(const f32x4*)(LB + ((size_t)((chunk * 4 + h) * 2 + dir) * 16384) + e4 * 4);
            S = S * g128 + Lc;
        }
    }
    for (int i = gt; i < 32 * 2 * 4 * 4096; i += NT) {
        const int e4 = i & 4095, h = (i >> 12) & 3, dir = (i >> 14) & 1, b = i >> 15;
        const float g128 = fexp(128.0f * log_gamma_of(A, l, dir, h));
        const int c_first = dir == 0 ? 0 : 1, c_second = 1 - c_first;
        const f32x4 L1 = *(const f32x4*)(LB + ((size_t)(((b * 2 + c_first) * 4 + h) * 2 + dir) * 16384) + e4 * 4);
        const f32x4 L2 = *(const f32x4*)(LB + ((size_t)(((b * 2 + c_second) * 4 + h) * 2 + dir) * 16384) + e4 * 4);
        *(f32x4*)(A.out + OUT_STATE + ((size_t)(((b * 2 + l) * 2 + dir) * 4 + h) * 16384) + e4 * 4) = L1 * g128 + L2;
    }
}
__device__ __forceinline__ void ret_pass3(Frame& F, int l) {
    CArgs& A = *get_args(); unsigned char* const WSP = A.ws; const int tid = F.tid;
    bf16* U = (bf16*)(WSP + WS_R1);
    LAS bf16* Qs = (LAS bf16*)F.lds; LAS bf16* KVs = Qs + 128 * 128; LAS float* As = (LAS float*)(F.lds + 65536);
    const float* LB = (const float*)(WSP + WS_T); const float* SB = (const float*)(WSP + WS_GS);
    for (int unit = F.vcu; unit < 512; unit += F.G) {
        const int chunk = unit >> 2, h = unit & 3, m0 = chunk * 128;
        __syncthreads();
        for (int i = tid; i < 2048; i += 512) { const int j = i >> 4, c8 = (i & 15) * 8;
            *(LAS v4u*)(Qs + j * 128 + c8) = *(const v4u*)(U + U_RQ + (size_t)(m0 + j) * 512 + h * 128 + c8);
            *(LAS v4u*)(KVs + j * 128 + c8) = *(const v4u*)(U + U_RK + (size_t)(m0 + j) * 512 + h * 128 + c8); }
        __syncthreads();
        const float lgf = log_gamma_of(A, l, 0, h), lgb = log_gamma_of(A, l, 1, h);
        const int i = tid >> 2, jq = tid & 3;
        {
            float acc[32];
#pragma unroll
            for (int jj = 0; jj < 32; ++jj) acc[jj] = 0.f;
            for (int db = 0; db < 16; ++db) {
                const v4u qw = *(const LAS v4u*)(Qs + i * 128 + db * 8);
                const float q8[8] = {blo(qw.x), bhi(qw.x), blo(qw.y), bhi(qw.y), blo(qw.z), bhi(qw.z), blo(qw.w), bhi(qw.w)};
#pragma unroll
                for (int jj = 0; jj < 32; ++jj) { const v4u kw = *(const LAS v4u*)(KVs + (jq + 4 * jj) * 128 + db * 8);
                    acc[jj] += q8[0] * blo(kw.x) + q8[1] * bhi(kw.x) + q8[2] * blo(kw.y) + q8[3] * bhi(kw.y) + q8[4] * blo(kw.z) + q8[5] * bhi(kw.z) + q8[6] * blo(kw.w) + q8[7] * bhi(kw.w); }
            }
#pragma unroll
            for (int jj = 0; jj < 32; ++jj) { const int j = jq + 4 * jj;
                const float dm = (i > j) ? fexp(lgf * (float)(i - j)) : ((j > i) ? fexp(lgb * (float)(j - i)) : 2.0f);
                As[i * 128 + j] = acc[jj] * dm * RET_SCALE; }
        }
        __syncthreads();
        for (int ii = tid; ii < 2048; ii += 512) { const int j = ii >> 4, c8 = (ii & 15) * 8;
            *(LAS v4u*)(KVs + j * 128 + c8) = *(const v4u*)(U + U_RV + (size_t)(m0 + j) * 512 + h * 128 + c8); }
        __syncthreads();
        const int e0 = jq * 32;
        float o[32];
#pragma unroll
        for (int e = 0; e < 32; ++e) o[e] = 0.f;
        for (int j = 0; j < 128; ++j) { const float a = As[i * 128 + j];
#pragma unroll
            for (int q = 0; q < 4; ++q) { const v4u vv = *(const LAS v4u*)(KVs + j * 128 + e0 + q * 8);
                o[q * 8 + 0] += a * blo(vv.x); o[q * 8 + 1] += a * bhi(vv.x); o[q * 8 + 2] += a * blo(vv.y); o[q * 8 + 3] += a * bhi(vv.y);
                o[q * 8 + 4] += a * blo(vv.z); o[q * 8 + 5] += a * bhi(vv.z); o[q * 8 + 6] += a * blo(vv.w); o[q * 8 + 7] += a * bhi(vv.w); } }
        const float* Sf = nullptr; const float* Sb = nullptr;
        if (chunk < 64) { const int b = chunk >> 1, c = chunk & 1;
            if (c == 1) Sf = LB + ((size_t)((((b * 2 + 0) * 4 + h) * 2 + 0)) * 16384); else Sb = LB + ((size_t)((((b * 2 + 1) * 4 + h) * 2 + 1)) * 16384);
        } else { const int lc = chunk - 64; Sf = SB + ((size_t)((lc * 4 + h) * 2 + 0) * 16384); Sb = SB + ((size_t)((lc * 4 + h) * 2 + 1) * 16384); }
        const float dqf = fexp(lgf * (float)(i + 1)), dqb = fexp(lgb * (float)(128 - i));
        if (Sf) { for (int d = 0; d < 128; ++d) { const float qd = bf2f(Qs[i * 128 + d]) * dqf; const float* sp = Sf + d * 128 + e0;
#pragma unroll
                for (int q = 0; q < 8; ++q) { const f32x4 s = *(const f32x4*)(sp + 4 * q); o[4 * q] += qd * s.x; o[4 * q + 1] += qd * s.y; o[4 * q + 2] += qd * s.z; o[4 * q + 3] += qd * s.w; } } }
        if (Sb) { for (int d = 0; d < 128; ++d) { const float qd = bf2f(Qs[i * 128 + d]) * dqb; const float* sp = Sb + d * 128 + e0;
#pragma unroll
                for (int q = 0; q < 8; ++q) { const f32x4 s = *(const f32x4*)(sp + 4 * q); o[4 * q] += qd * s.x; o[4 * q + 1] += qd * s.y; o[4 * q + 2] += qd * s.z; o[4 * q + 3] += qd * s.w; } } }
        float ss = 0.f;
#pragma unroll
        for (int e = 0; e < 32; ++e) ss += o[e] * o[e];
        ss += __shfl_xor(ss, 1); ss += __shfl_xor(ss, 2);
        const float r = frsq(ss * (1.0f / 128.0f) + EPS);
        const float* gn = A.in[I_RETGN] + l * 512 + h * 128 + e0;
        const bf16* sg = U + U_SRG + (size_t)(m0 + i) * 512 + h * 128 + e0;
        bf16* op = U + U_RQ + (size_t)(m0 + i) * 512 + h * 128 + e0;
#pragma unroll
        for (int q = 0; q < 4; ++q) { const v4u g = *(const v4u*)(sg + q * 8);
            const float g8[8] = {blo(g.x), bhi(g.x), blo(g.y), bhi(g.y), blo(g.z), bhi(g.z), blo(g.w), bhi(g.w)};
            float y[8];
#pragma unroll
            for (int e = 0; e < 8; ++e) y[e] = o[q * 8 + e] * r * gn[q * 8 + e] * g8[e];
            v4u w; w.x = pk2(y[0], y[1]); w.y = pk2(y[2], y[3]); w.z = pk2(y[4], y[5]); w.w = pk2(y[6], y[7]);
            *(v4u*)(op + q * 8) = w; }
    }
}
__device__ __forceinline__ void attn_naive(Frame& F, int l) {
    CArgs& A = *get_args(); unsigned char* const WSP = A.ws;
    const int tid = F.tid;
    bf16* U = (bf16*)(WSP + WS_R1);
    LAS bf16* KT = (LAS bf16*)F.lds;
    LAS bf16* VT = KT + 64 * 64;
    const int tq = tid >> 1, dh = (tid & 1) * 32;
    for (int it = F.vcu; it < 512; it += F.G) {
        int m0, hh, S; const bf16* Kb; const bf16* Vb;
        if (it >= 256) { const int i = it - 256, b = i >> 3; hh = i & 7; m0 = b * 256; S = 256;
            Kb = (const bf16*)(WSP + WS_KC) + (size_t)(b * 2 + (hh >> 2)) * 256 * 64; Vb = (const bf16*)(WSP + WS_VC) + (size_t)(b * 2 + (hh >> 2)) * 256 * 64;
        } else { const int b = it >> 7, qb = it & 15; hh = (it >> 4) & 7; m0 = MCTX + b * SEQL + qb * 256; S = SKL;
            Kb = (const bf16*)(WSP + WS_KL) + (size_t)((l * 2 + b) * 2 + (hh >> 2)) * SKL * 64; Vb = (const bf16*)(WSP + WS_VL) + (size_t)((l * 2 + b) * 2 + (hh >> 2)) * SKL * 64; }
        bf16* qp = U + U_AQ + (size_t)(m0 + tq) * 512 + hh * 64 + dh;
        float q[32], o[32];
#pragma unroll
        for (int c = 0; c < 4; ++c) { const v4u w = *(const v4u*)(qp + c * 8);
            q[c * 8] = blo(w.x); q[c * 8 + 1] = bhi(w.x); q[c * 8 + 2] = blo(w.y); q[c * 8 + 3] = bhi(w.y); q[c * 8 + 4] = blo(w.z); q[c * 8 + 5] = bhi(w.z); q[c * 8 + 6] = blo(w.w); q[c * 8 + 7] = bhi(w.w); }
#pragma unroll
        for (int d = 0; d < 32; ++d) o[d] = 0.f;
        float mrun = -INFINITY, lrun = 0.f;
        const int ntile = S >> 6;
        for (int t = 0; t < ntile; ++t) {
            __syncthreads();
            { const int r = tid >> 3, c8 = (tid & 7) * 8; const size_t g = (size_t)(t * 64 + r) * 64 + c8;
              *(LAS v4u*)(KT + r * 64 + c8) = *(const v4u*)(Kb + g); *(LAS v4u*)(VT + r * 64 + c8) = *(const v4u*)(Vb + g); }
            __syncthreads();
#pragma unroll 1
            for (int jb = 0; jb < 64; jb += 4) {
                float s[4]; float tmax = -INFINITY;
#pragma unroll
                for (int j = 0; j < 4; ++j) { float a = 0.f;
#pragma unroll
                    for (int c = 0; c < 4; ++c) { const v4u w = *(const LAS v4u*)(KT + (jb + j) * 64 + dh + c * 8);
                        a += q[c * 8] * blo(w.x) + q[c * 8 + 1] * bhi(w.x) + q[c * 8 + 2] * blo(w.y) + q[c * 8 + 3] * bhi(w.y) + q[c * 8 + 4] * blo(w.z) + q[c * 8 + 5] * bhi(w.z) + q[c * 8 + 6] * blo(w.w) + q[c * 8 + 7] * bhi(w.w); }
                    a += __shfl_xor(a, 1);
                    s[j] = a; tmax = fmaxf(tmax, a); }
                const float mnew = fmaxf(mrun, tmax), alpha = fexp2(mrun - mnew);
                lrun *= alpha;
#pragma unroll
                for (int d = 0; d < 32; ++d) o[d] *= alpha;
#pragma unroll
                for (int j = 0; j < 4; ++j) { const float p = fexp2(s[j] - mnew); lrun += p;
#pragma unroll
                    for (int c = 0; c < 4; ++c) { const v4u w = *(const LAS v4u*)(VT + (jb + j) * 64 + dh + c * 8);
                        o[c * 8] += p * blo(w.x); o[c * 8 + 1] += p * bhi(w.x); o[c * 8 + 2] += p * blo(w.y); o[c * 8 + 3] += p * bhi(w.y); o[c * 8 + 4] += p * blo(w.z); o[c * 8 + 5] += p * bhi(w.z); o[c * 8 + 6] += p * blo(w.w); o[c * 8 + 7] += p * bhi(w.w); } }
                mrun = mnew;
            }
        }
        const float inv = 1.0f / lrun;
#pragma unroll
        for (int c = 0; c < 4; ++c) { float y[8];
#pragma unroll
            for (int e = 0; e < 8; ++e) y[e] = o[c * 8 + e] * inv;
            v4u w; w.x = pk2(y[0], y[1]); w.y = pk2(y[2], y[3]); w.z = pk2(y[4], y[5]); w.w = pk2(y[6], y[7]);
            *(v4u*)(qp + c * 8) = w; }
    }
    __syncthreads();
}


#ifndef DBG
#define DBG 0
#endif
#if DBG
constexpr int CW_DBG = 2048;
__device__ __forceinline__ void dbg_report(unsigned* ctl, int check, float got, float ref, int lane) {
    const float err = fabsf(got - ref), tol = 0.05f * fabsf(ref) + 0.05f;
    const float rel = err / (fabsf(ref) + 0.5f);
    if (!(err <= tol)) atomicOr(ctl + CW_DBG, 1u << check);
    atomicMax(ctl + CW_DBG + 1 + check, __float_as_uint(rel == rel ? rel : 1e30f));
    atomicAdd((float*)(ctl + CW_DBG + 64 + 2 * check), err * err); atomicAdd((float*)(ctl + CW_DBG + 65 + 2 * check), ref * ref);
}
__device__ __forceinline__ float dbg_dot(const bf16* arow, const float* W, int K, int srcN, int col, int lane) {
    float a = 0.f; for (int k = lane; k < K; k += 64) a += bf2f(arow[k]) * W[(size_t)k * srcN + col]; return wave_sum(a);
}
__device__ __forceinline__ float dbg_sig(float x) { return 1.0f / (1.0f + __expf(-x)); }
__device__ __forceinline__ float dbg_qk_dim(CArgs& A, unsigned char* ws, int l, int m, int slot, int lane) {
    const bf16* xn = (const bf16*)(ws + WS_XN) + (size_t)m * DM;
    const float* W = A.in[I_WIN] + (size_t)l * DM * NIN_SRC;
    const int col0 = slot < 8 ? 2048 + slot * 64 : 2560 + (slot - 8) * 64;
    float mine = 0.f;
    for (int d = 0; d < 64; ++d) { const float v = dbg_dot(xn, W, DM, NIN_SRC, col0 + d, lane); if (d == lane) mine = v; }
    mine = bf2f((unsigned short)f2bf(mine));
    const float ss = wave_sum(mine * mine);
    const float g = slot < 8 ? A.in[I_QG][l * 64 + lane] : A.in[I_KG][l * 64 + lane];
    float y = mine * (1.0f / sqrtf(ss / 64.0f + EPS)) * g;
    if (m >= MCTX) {
        const int t = (m - MCTX) % SEQL, row = t / 64, colp = t % 64, i = lane & 31;
        const float pos = (i < 16) ? (float)row : (float)colp; const int fi = i & 15;
        const float inv = __powf(10000.0f, -(float)fi / 16.0f); const float ang = pos * inv;
        const float c = __cosf(ang), sn = __sinf(ang);
        const float other = __shfl_xor(y, 32);
        y = (lane < 32) ? (y * c - other * sn) : (other * sn + y * c);
    }
    return y;
}
__device__ __forceinline__ void dbg_checks(Frame& F, int check) {
    CArgs& A = *get_args(); unsigned char* const ws = A.ws; unsigned* ctl = (unsigned*)(ws + WS_CTL);
    const int gw = F.bx * NWAVES + F.wave, lane = F.lane;
    const float* mod = (const float*)(ws + WS_MOD);
    const bf16* XN = (const bf16*)(ws + WS_XN); const bf16* U = (const bf16*)(ws + WS_R1);
    if (check == 40) {
        const bf16* WG = (const bf16*)(ws + WS_WG); const bf16* GSb = (const bf16*)(ws + WS_GS);
        for (size_t o = (size_t)F.bx * 512 + F.tid; o < (size_t)MTOK * DM; o += (size_t)F.G * 512) {
            const int mm = (int)(o >> 10), n = (int)(o & 1023); const v4u* xr = (const v4u*)(XN + (size_t)mm * DM); const v4u* wr_ = (const v4u*)(WG + (size_t)n * DM);
            float acc = 0.f;
            for (int k8 = 0; k8 < 128; ++k8) { const v4u a = xr[k8], b = wr_[k8];
                acc += blo(a.x) * blo(b.x) + bhi(a.x) * bhi(b.x) + blo(a.y) * blo(b.y) + bhi(a.y) * bhi(b.y) + blo(a.z) * blo(b.z) + bhi(a.z) * bhi(b.z) + blo(a.w) * blo(b.w) + bhi(a.w) * bhi(b.w); }
            const float ref = dbg_sig(acc), got = bf2f(GSb[o]);
            if ((mm & 255) >= 128 && (mm & 63) >= 48 && (n & 128)) { const float raw = ((const float*)(ws + WS_T))[o]; if (!(fabsf(raw - acc) <= 0.02f + 0.01f * fabsf(acc))) atomicAdd(ctl + CW_DBG + 210, 1u); else atomicAdd(ctl + CW_DBG + 211, 1u); }
            if (!(fabsf(got - ref) <= 0.02f)) { atomicAdd(ctl + CW_DBG + 200, 1u); atomicAdd(ctl + CW_DBG + 256 + (mm >> 8), 1u); atomicAdd(ctl + CW_DBG + 384 + (mm & 255), 1u); atomicAdd(ctl + CW_DBG + 201 + ((n >> 7) & 1), 1u); }
        }
        return; }
    if (check == 41) {
        const bf16* WI = (const bf16*)(ws + WS_WINM) + (size_t)1536 * DM; const bf16* SR = U + U_SRG;
        for (size_t o = (size_t)F.bx * 512 + F.tid; o < (size_t)MTOK * 512; o += (size_t)F.G * 512) {
            const int mm = (int)(o >> 9), n = (int)(o & 511); const v4u* xr = (const v4u*)(XN + (size_t)mm * DM); const v4u* wr_ = (const v4u*)(WI + (size_t)n * DM);
            float acc = 0.f;
            for (int k8 = 0; k8 < 128; ++k8) { const v4u a = xr[k8], b = wr_[k8];
                acc += blo(a.x) * blo(b.x) + bhi(a.x) * bhi(b.x) + blo(a.y) * blo(b.y) + bhi(a.y) * bhi(b.y) + blo(a.z) * blo(b.z) + bhi(a.z) * bhi(b.z) + blo(a.w) * blo(b.w) + bhi(a.w) * bhi(b.w); }
            const float ref = acc * dbg_sig(acc), got = bf2f(SR[o]);
            if (!(fabsf(got - ref) <= 0.02f + 0.02f * fabsf(ref))) { atomicAdd(ctl + CW_DBG + 200, 1u); atomicAdd(ctl + CW_DBG + 256 + (mm >> 8), 1u); atomicAdd(ctl + CW_DBG + 384 + (mm & 255), 1u); atomicAdd(ctl + CW_DBG + 201 + ((n >> 7) & 1), 1u); }
        }
        return; }
    if (check == 30 || check == 31) {
        const unsigned* X = (const unsigned*)XN; unsigned acc = 0, accf = 0;
        for (size_t i = (size_t)F.bx * 512 + F.tid; i < (size_t)MTOK * DM / 2; i += (size_t)F.G * 512) { const unsigned w = X[i]; acc += w * 2654435761u + (unsigned)i; const size_t row = i / 512; if (row >= 10168 && row < 10176) accf += w * 2654435761u + (unsigned)i; }
        atomicAdd(ctl + CW_DBG + 100 + (check - 30), acc); atomicAdd(ctl + CW_DBG + 102 + (check - 30), accf);
        return; }
    if (check >= 20 && check < 26) {
        const int step = check - 20, b = step >> 1; const float* W = A.in[I_WIN];
        for (int rep = 0; rep < 4; ++rep) { const int m = 10168 + (gw & 7); const int n = ((gw >> 3) + 256 * rep) % DM;
            float tsum = 0.f, gl = 0.f;
            for (int bb = 0; bb <= b; ++bb) { const float g = dbg_sig(dbg_dot(XN + (size_t)m * DM, W, DM, NIN_SRC, NINM + 1024 * bb + n, lane)); gl = g;
                if (bb < b || (step & 1)) { const bf16* Ab = U + (bb == 0 ? U_RQ : (bb == 1 ? U_AQ : U_CB)) + (size_t)m * 512;
                    const float* Wo = (bb == 0 ? A.in[I_WRO] : (bb == 1 ? A.in[I_WAO] : A.in[I_WCO])); tsum += g * dbg_dot(Ab, Wo, 512, DM, n, lane); } }
            if (step == 0) { float mx = 0.f; for (int k = lane; k < DM; k += 64) mx = fmaxf(mx, fabsf(bf2f(XN[(size_t)m * DM + k])));
                for (int o = 1; o < 64; o <<= 1) mx = fmaxf(mx, __shfl_xor(mx, o));
                float a2 = 0.f; for (int k = lane; k < DM; k += 64) a2 += bf2f(XN[(size_t)m * DM + k]) * bf2f((unsigned short)f2bf(W[(size_t)k * NIN_SRC + NINM + n])); a2 = dbg_sig(wave_sum(a2));
                float rn = 0.f; for (int k = lane; k < DM; k += 64) { const float x = bf2f(XN[(size_t)m * DM + k]); rn += x * x; } rn = sqrtf(wave_sum(rn));
                if (lane == 0) { atomicMax(ctl + CW_DBG + 61, __float_as_uint(rn)); const float gsv = bf2f(((const bf16*)(ws + WS_GS))[(size_t)m * DM + n]); if (!(fabsf(gsv - gl) <= 0.05f * gl + 0.05f)) atomicAdd(ctl + CW_DBG + 60, 1u);
                    if (!(fabsf(gsv - a2) <= 0.05f * a2 + 0.05f)) { atomicAdd(ctl + CW_DBG + 62, 1u); atomicOr(ctl + CW_DBG + 110, 1u << (n >> 7)); atomicOr(ctl + CW_DBG + 111, 1u << ((n >> 3) & 15)); atomicOr(ctl + CW_DBG + 112, 1u << (n & 7)); } } }
            if (lane == 0) { if ((step & 1) == 0) dbg_report(ctl, step, bf2f(((const bf16*)(ws + WS_GS))[(size_t)m * DM + n]), gl, lane);
                else if (b < 2) dbg_report(ctl, step, ((const float*)(ws + WS_T))[(size_t)m * DM + n], tsum, lane);
                else dbg_report(ctl, step, bf2f(U[U_MG + (size_t)m * DM + n]), tsum, lane); } }
        return; }
    const int l = check >= 16 ? 1 : 0; check &= 15; const int rb01 = (l == 1) ? 3 : check;
  for (int rep = 0; rep < 4; ++rep) {
    const int m = 10168 + (gw & 7); const int ci = cond_of_row(m); const int sidx = (gw >> 3) + 256 * rep;
    if (check == 0) {
        if (rep > 0) continue;
        const int h = sidx & 3;
        const bf16* xn = XN + (size_t)m * DM; const float* W = A.in[I_WIN] + (size_t)l * DM * NIN_SRC;
        float q0 = 0.f, q1 = 0.f;
        for (int d = 0; d < 128; ++d) { float a = 0.f; for (int k = lane; k < DM; k += 64) a += bf2f(xn[k]) * bf2f((unsigned short)f2bf(W[(size_t)k * NIN_SRC + h * 128 + d])); const float v = bf2f((unsigned short)f2bf(wave_sum(a))); if (d == lane) q0 = v; if (d == lane + 64) q1 = v; }
        int mb, T, n; const float* S0f = nullptr; const float* S0b = nullptr;
        if (m < MCTX) { mb = m & ~255; T = 256; n = m & 255; } else { const int bb = (m - MCTX) >> 12; mb = MCTX + bb * SEQL; T = SEQL; n = (m - MCTX) & (SEQL - 1);
            S0f = A.in[I_STATE] + ((size_t)(((bb * 2 + l) * 2 + 0) * 4 + h) * 16384); S0b = A.in[I_STATE] + ((size_t)(((bb * 2 + l) * 2 + 1) * 4 + h) * 16384); }
        const float xf = A.in[I_DECAY][(l * 2 + 0) * 4 + h], xb = A.in[I_DECAY][(l * 2 + 1) * 4 + h];
        const float lgf = -logf(1.0f + __expf(-xf)), lgb = -logf(1.0f + __expf(-xb));
        float o0 = 0.f, o1 = 0.f;
        for (int j = 0; j < T; ++j) {
            const bf16* kr = U + U_RK + (size_t)(mb + j) * 512 + h * 128; const bf16* vr = U + U_RV + (size_t)(mb + j) * 512 + h * 128;
            const float sdot = wave_sum(q0 * bf2f(kr[lane]) + q1 * bf2f(kr[lane + 64])) * RET_SCALE;
            const float w = (j < n) ? __expf(lgf * (float)(n - j)) : ((j > n) ? __expf(lgb * (float)(j - n)) : 2.0f);
            o0 += w * sdot * bf2f(vr[lane]); o1 += w * sdot * bf2f(vr[lane + 64]);
        }
        if (S0f) { const float df = __expf(lgf * (float)(n + 1)), db = __expf(lgb * (float)(T - n));
            for (int d = 0; d < 128; ++d) { const float qd = __shfl(d < 64 ? q0 : q1, d & 63);
                o0 += qd * (df * S0f[d * 128 + lane] + db * S0b[d * 128 + lane]); o1 += qd * (df * S0f[d * 128 + lane + 64] + db * S0b[d * 128 + lane + 64]); } }
        const float r = 1.0f / sqrtf(wave_sum(o0 * o0 + o1 * o1) / 128.0f + EPS);
        const float* gn = A.in[I_RETGN] + l * 512 + h * 128;
        const float r0 = o0 * r * gn[lane] * bf2f(U[U_SRG + (size_t)m * 512 + h * 128 + lane]), r1 = o1 * r * gn[lane + 64] * bf2f(U[U_SRG + (size_t)m * 512 + h * 128 + lane + 64]);
        { const int slot = rb01; dbg_report(ctl, slot, bf2f(U[U_RQ + (size_t)m * 512 + h * 128 + lane]), r0, lane); dbg_report(ctl, slot, bf2f(U[U_RQ + (size_t)m * 512 + h * 128 + lane + 64]), r1, lane); }
    } else if (check == 1) {
        if (rep > 0) continue;
        const int h = sidx & 7, kv = h >> 2; const float q = dbg_qk_dim(A, ws, l, m, h, lane) * 0.125f;
        const bf16* Kb; const bf16* Vb; int S;
        if (m < MCTX) { const int bb = m >> 8; S = 256; Kb = (const bf16*)(ws + WS_KC) + (size_t)(bb * 2 + kv) * 256 * 64; Vb = (const bf16*)(ws + WS_VC) + (size_t)(bb * 2 + kv) * 256 * 64; }
        else { const int bb = (m - MCTX) >> 12; S = SKL; Kb = (const bf16*)(ws + WS_KL) + (size_t)((l * 2 + bb) * 2 + kv) * SKL * 64; Vb = (const bf16*)(ws + WS_VL) + (size_t)((l * 2 + bb) * 2 + kv) * SKL * 64; }
        float mx = -1e30f; for (int j = 0; j < S; ++j) mx = fmaxf(mx, wave_sum(q * bf2f(Kb[(size_t)j * 64 + lane])));
        float den = 0.f, o = 0.f; for (int j = 0; j < S; ++j) { const float p = __expf(wave_sum(q * bf2f(Kb[(size_t)j * 64 + lane])) - mx); den += p; o += p * bf2f(Vb[(size_t)j * 64 + lane]); }
        dbg_report(ctl, rb01, bf2f(U[U_AQ + (size_t)m * 512 + h * 64 + lane]), o / den, lane);
    } else if (check == 2) {
        const int n = sidx % DM; const float* W = A.in[I_WIN] + (size_t)l * DM * NIN_SRC; float ref = 0.f; float term[3];
        for (int b = 0; b < 3; ++b) { const float g = dbg_dot(XN + (size_t)m * DM, W, DM, NIN_SRC, NINM + 1024 * b + n, lane);
            const bf16* Ab = U + (b == 0 ? U_RQ : (b == 1 ? U_AQ : U_CB)) + (size_t)m * 512;
            const float* Wo = (b == 0 ? A.in[I_WRO] : (b == 1 ? A.in[I_WAO] : A.in[I_WCO])) + (size_t)l * 512 * DM;
            term[b] = dbg_sig(g) * dbg_dot(Ab, Wo, 512, DM, n, lane); ref += term[b]; }
        if (lane == 0) { dbg_report(ctl, 2, bf2f(U[U_MG + (size_t)m * DM + n]), ref, lane);
            const float got = bf2f(U[U_MG + (size_t)m * DM + n]); if (!(fabsf(got - ref) <= 0.05f * fabsf(ref) + 0.05f)) { atomicAdd(ctl + CW_DBG + 60, 1u);
                for (int b = 0; b < 3; ++b) { const float alt = ref - term[b]; if (fabsf(got - alt) <= 0.05f * fabsf(alt) + 0.05f) atomicAdd(ctl + CW_DBG + 50 + b, 1u); }
                const float gs = bf2f(((const bf16*)(ws + WS_GS))[(size_t)m * DM + n]); const float tt = ((const float*)(ws + WS_T))[(size_t)m * DM + n];
                const float t01 = term[0] + term[1]; if (!(fabsf(tt - t01) <= 0.05f * fabsf(t01) + 0.05f)) atomicAdd(ctl + CW_DBG + 53, 1u);
                const float g2 = dbg_sig(dbg_dot(XN + (size_t)m * DM, W, DM, NIN_SRC, NINM + 2048 + n, lane)); (void)g2; } }
    } else if (check == 3) {
        if (rep > 0) continue;
        float* T = (float*)(ws + WS_T); for (size_t i = (size_t)F.bx * 512 + F.tid; i < (size_t)MTOK * DM; i += (size_t)F.G * 512) T[i] = A.out[i];
    } else if (check == 4) {
        const int n = sidx % DM; const float* T = (const float*)(ws + WS_T);
        const float d = dbg_dot(U + U_MG + (size_t)m * DM, A.in[I_WO] + (size_t)l * DM * DM, DM, DM, n, lane);
        const float ref = T[(size_t)m * DM + n] + mod[(size_t)(ci * 2 + l) * 9216 + 5 * 1024 + n] * d;
        if (lane == 0) dbg_report(ctl, 4, A.out[(size_t)m * DM + n], ref, lane);
    } else if (check == 5 || check == 9) {
        const int j = check == 5 ? 2 : 0; const float* x = A.out + (size_t)m * DM;
        float s2 = 0.f; for (int k = lane; k < DM; k += 64) s2 += x[k] * x[k];
        s2 = wave_sum(s2); const float rstd = 1.0f / sqrtf(s2 / DM + EPS);
        const int k = lane * 16 + 3; const float* mm = mod + (size_t)(ci * 2 + l) * 9216 + 3 * j * 1024;
        const float ref = x[k] * rstd * A.in[I_NORMW][(l * 3 + j) * DM + k] * (1.0f + mm[1024 + k]) + mm[k];
        dbg_report(ctl, check, bf2f(XN[(size_t)m * DM + k]), ref, lane);
    } else if (check == 6 || check == 10) {
        const int f = check == 6 ? 1 : 0; const int j = (gw * 131 + 5) % FFN; const float* W = A.in[I_WFFIN] + (size_t)(l * 2 + f) * DM * NFF1;
        const float g = dbg_dot(XN + (size_t)m * DM, W, DM, NFF1, j, lane), u = dbg_dot(XN + (size_t)m * DM, W, DM, NFF1, FFN + j, lane);
        if (lane == 0) dbg_report(ctl, check, bf2f(U[(size_t)m * FFN + j]), g * dbg_sig(g) * u, lane);
    } else if (check == 7) {
        const int n = (gw * 61 + 3) % DM; const float* T = (const float*)(ws + WS_T);
        const float d = dbg_dot(U + (size_t)m * FFN, A.in[I_WFFOUT] + (size_t)(l * 2 + 1) * FFN * DM, FFN, DM, n, lane);
        const float ref = T[(size_t)m * DM + n] + 0.5f * mod[(size_t)(ci * 2 + l) * 9216 + 8 * 1024 + n] * d;
        if (lane == 0) dbg_report(ctl, 7, A.out[(size_t)m * DM + n], ref, lane);
    } else if (check == 11) {
        float mx = 0.f; for (size_t i = (size_t)F.bx * 512 + F.tid; i < (size_t)MTOK * DM; i += (size_t)F.G * 512) { const float v = fabsf(A.out[i]); mx = fmaxf(mx, (v == v) ? v : 1e30f); }
        mx = fmaxf(mx, __shfl_xor(mx, 1)); mx = fmaxf(mx, __shfl_xor(mx, 2)); mx = fmaxf(mx, __shfl_xor(mx, 4)); mx = fmaxf(mx, __shfl_xor(mx, 8)); mx = fmaxf(mx, __shfl_xor(mx, 16)); mx = fmaxf(mx, __shfl_xor(mx, 32));
        if (lane == 0) atomicMax(ctl + CW_DBG + 40, __float_as_uint(mx));
    } else if (check == 13) {
        for (int p = 0; p < 3; ++p) { const bf16* P = U + (p == 0 ? U_RQ : (p == 1 ? U_AQ : U_CB)); float mx = 0.f;
            for (size_t i = (size_t)F.bx * 512 + F.tid; i < PLANE; i += (size_t)F.G * 512) { const float v = fabsf(bf2f(P[i])); mx = fmaxf(mx, (v == v) ? v : 1e30f); }
            mx = fmaxf(mx, __shfl_xor(mx, 1)); mx = fmaxf(mx, __shfl_xor(mx, 2)); mx = fmaxf(mx, __shfl_xor(mx, 4)); mx = fmaxf(mx, __shfl_xor(mx, 8)); mx = fmaxf(mx, __shfl_xor(mx, 16)); mx = fmaxf(mx, __shfl_xor(mx, 32));
            if (lane == 0) atomicMax(ctl + CW_DBG + 44 + p, __float_as_uint(mx)); }
    } else if (check == 14) {
        const float mxv = __uint_as_float(ctl[CW_DBG + 40]);
        for (size_t i = (size_t)F.bx * 512 + F.tid; i < (size_t)MTOK * DM; i += (size_t)F.G * 512) { const float v = fabsf(A.out[i]); if (v >= 0.999f * mxv) atomicMax(ctl + CW_DBG + 47, 0x7fffffffu - (unsigned)i); }
    } else if (check == 12) {
        if (F.bx == 0 && F.tid == 0) { const float mx = __uint_as_float(ctl[CW_DBG + 40]); if (mx > 30.f && ctl[CW_DBG + 41] == 0u) { ctl[CW_DBG + 41] = 1u + ctl[CW_DBG + 42]; ctl[CW_DBG + 43] = __float_as_uint(mx); } ctl[CW_DBG + 42] += 1u; }
    } else if (check == 8) {
        int c = (sidx * 4 + (gw & 3)) % NINM; if (c >= 3840) c -= 512;
        const float* W = A.in[I_WIN] + (size_t)l * DM * NIN_SRC;
        float ref = dbg_dot(XN + (size_t)m * DM, W, DM, NIN_SRC, c, lane), got;
        if (c < 512) got = bf2f(U[U_RQ + (size_t)m * 512 + c]);
        else if (c < 1024) got = bf2f(U[U_RK + (size_t)m * 512 + c - 512]);
        else if (c < 1536) got = bf2f(U[U_RV + (size_t)m * 512 + c - 1024]);
        else if (c < 2048) { got = bf2f(U[U_SRG + (size_t)m * 512 + c - 1536]); ref = ref * dbg_sig(ref); }
        else if (c < 2560) got = bf2f(U[U_AQ + (size_t)m * 512 + c - 2048]);
        else if (c < 2816) got = bf2f(U[U_AKV + (size_t)m * 256 + c - 2560]);
        else if (c < 3328) got = bf2f(U[U_CB + (size_t)m * 512 + c - 2816]);
        else { ref *= dbg_dot(XN + (size_t)m * DM, W, DM, NIN_SRC, c + 512, lane); got = bf2f(U[U_P + (size_t)m * 512 + c - 3328]); }
        if (lane == 0) dbg_report(ctl, 8, got, ref, lane);
    }
  }
}
__device__ __forceinline__ void dbg_final(Frame& F) {
    CArgs& A = *get_args(); unsigned* ctl = (unsigned*)(A.ws + WS_CTL);
    if (F.bx == 0 && F.tid == 0) {
        const unsigned mask = ctl[CW_DBG];
#if DBG == 2
        const unsigned same_all = (ctl[CW_DBG + 100] == ctl[CW_DBG + 101]) ? 1u : 0u, same_foc = (ctl[CW_DBG + 102] == ctl[CW_DBG + 103]) ? 1u : 0u;
        (void)same_all; (void)same_foc;
        const unsigned tot = ctl[CW_DBG + 60]; int lb = 0; { unsigned t = 1; while (lb < 14 && tot >= t) { ++lb; t <<= 1; } }
        const float mxx = __uint_as_float(ctl[CW_DBG + 61]); int bx2 = 0; { float t = 2.f; while (bx2 < 20 && mxx >= t) { ++bx2; t *= 2.f; } }
        const unsigned tot2 = ctl[CW_DBG + 62]; int lb2 = 0; { unsigned t = 1; while (lb2 < 9 && tot2 >= t) { ++lb2; t <<= 1; } }
        { const unsigned tot = ctl[CW_DBG + 200]; int lb = 0; { unsigned t = 1; while (lb < 30 && tot >= t) { ++lb; t <<= 1; } }
          int ntile = 0; for (int q = 0; q < 64; ++q) ntile += ctl[CW_DBG + 256 + q] ? 1 : 0; int nrow = 0; for (int q = 0; q < 256; ++q) nrow += ctl[CW_DBG + 384 + q] ? 1 : 0;
          int lr = 0; { int t = 1; while (lr < 9 && nrow >= t) { ++lr; t <<= 1; } }
#if DBG_WHICH == 0
          int minr = 255, maxr = 0; for (int q = 0; q < 256; ++q) if (ctl[CW_DBG + 384 + q] > 8u) { if (q < minr) minr = q; if (q > maxr) maxr = q; }
          { const unsigned bad = ctl[CW_DBG + 210], good = ctl[CW_DBG + 211]; int l1 = 0, l2 = 0; { unsigned t = 1; while (l1 < 30 && bad >= t) { ++l1; t <<= 1; } } { unsigned t = 1; while (l2 < 30 && good >= t) { ++l2; t <<= 1; } }
            float v = (float)(10 + l1) * 1e4f; for (int i = 0; i < l2; ++i) v *= 10.0f; A.out[0] = v; return; }
          (void)ntile; (void)lb; (void)minr; (void)maxr; int c4[4]; for (int g = 0; g < 4; ++g) { c4[g] = 0; for (int q = 0; q < 4; ++q) c4[g] += (ctl[CW_DBG + 384 + 176 + 4 * g + q] > 8u) ? 1 : 0; }
          int nall = 0; for (int q = 0; q < 256; ++q) nall += (ctl[CW_DBG + 384 + q] > 8u) ? 1 : 0;
          float v = (float)(10 + c4[0] * 5 + c4[1]) * 1e4f; for (int i = 0; i < c4[2] * 5 + c4[3]; ++i) v *= 10.0f; if (nall != 24) v = -v; A.out[0] = v; return;
#else
          const unsigned b0 = ctl[CW_DBG + 201], b1c = ctl[CW_DBG + 202]; int l0 = 0; { unsigned t = 1; while (l0 < 30 && b0 >= t) { ++l0; t <<= 1; } } (void)b1c;
          float v = (float)(10 + lr * 9) * 1e4f; for (int i = 0; i < l0; ++i) v *= 10.0f; A.out[0] = v; return;
#endif
        }
        const unsigned g128 = ctl[CW_DBG + 110] & 255u, g8 = ctl[CW_DBG + 111] & 0xffffu, g1 = ctl[CW_DBG + 112] & 255u;
#if DBG_WHICH == 0
        float v = (float)(10u + (g128 & 63u)) * 1e4f; for (unsigned i = 0; i < (g128 >> 6) + 4u * (g1 == 255u ? 1u : 0u); ++i) v *= 10.0f; A.out[0] = v;
#else
        float v = (float)(10u + (g8 & 63u)) * 1e4f; for (unsigned i = 0; i < (g8 >> 6); ++i) v *= 10.0f; A.out[0] = v;
#endif
#else
        float v = (float)(10u + (mask & 63u)) * 1e4f; for (unsigned i = 0; i < (mask >> 6); ++i) v *= 10.0f;
        A.out[0] = v;
#endif
    }
}
#endif

enum { K_PRO = 0, K_NORM, K_FFN_UP, K_FFN_DOWN, K_WIN, K_MIX1, K_SCAN, K_MIX2, K_MERGE, K_WO, K_XLAYER };
constexpr int N_PHASES = 27;
__device__ __forceinline__ void decode_phase(int ph, int& kind, int& l, int& sub) {
    if (ph >= 3000) { kind = 98; l = 0; sub = ph - 3000; return; }
    if (ph >= 1000) { kind = 99; l = 0; sub = ph - 1000; return; }
    if (ph == 0) { kind = K_PRO; l = 0; sub = 0; return; }
    if (ph == 1) { kind = K_NORM; l = 0; sub = 0; return; }
    const int q = ph - 2; l = q / 13; const int r = q % 13; sub = 0;
    switch (r) {
        case 0: kind = K_FFN_UP; sub = 0; break;
        case 1: kind = K_FFN_DOWN; sub = 0; break;
        case 2: kind = K_NORM; sub = 1; break;
        case 3: kind = K_WIN; break;
        case 4: kind = K_MIX1; break;
        case 5: kind = K_SCAN; break;
        case 6: kind = K_MIX2; break;
        case 7: kind = K_MERGE; break;
        case 8: kind = K_WO; break;
        case 9: kind = K_NORM; sub = 2; break;
        case 10: kind = K_FFN_UP; sub = 1; break;
        case 11: kind = K_FFN_DOWN; sub = 1; break;
        default: kind = K_XLAYER; break;
    }
}

__global__ void __launch_bounds__(NWAVES * 64, 2) trunk_fwd(Args args_unused) {
    extern __shared__ __attribute__((aligned(16))) unsigned char lds[];
    Frame F;
    F.lds = (LAS unsigned char*)lds;
    { const int t0 = threadIdx.x; for (int u = t0; u < (LDS_BYTES - RING_BYTES) / 4; u += NWAVES * 64) ((LAS unsigned*)(F.lds + RING_BYTES))[u] = 0u; }
    __syncthreads();
    int ph_lo, ph_hi; { CArgs* A0 = get_args(); ph_lo = A0->ph_lo; ph_hi = A0->ph_hi; }
    unsigned bar_x = 0;
    if (ph_hi - ph_lo > 1) { CArgs* A0 = get_args(); XcdBarrier b0 = xcd_barrier_post((unsigned*)(A0->ws + WS_CTL) + CW_BAR, (volatile LAS unsigned*)(F.lds + MISC_OFF) + 8); bar_x = b0.x; }

    for (int ph = ph_lo; ph < ph_hi; ++ph) {
        { int t = threadIdx.x; asm volatile("" : "+v"(t)); F.tid = t; F.lane = t & 63; F.wave = __builtin_amdgcn_readfirstlane(t >> 6); }
        { int bx = blockIdx.x, G = gridDim.x; asm volatile("" : "+s"(bx), "+s"(G)); F.G = G; F.vcu = (G % 8 == 0) ? (bx % 8) * (G / 8) + bx / 8 : bx; F.bx = bx; }
        int kind, l, sub; decode_phase(ph, kind, l, sub);
        switch (kind) {
        case K_PRO: { if (EN_PRO) { compute_mod(F); prologue_misc(F); __syncthreads(); convert_weights(F, 0); } } break;
        case K_NORM: { modnorm_rows(F, l, sub, (l == 0 && sub == 0)); } break;
        case K_FFN_UP: {
            CArgs& A = *get_args(); unsigned char* const ws = A.ws;
            pg8::Gemm g{(const pg8::bf16_t*)(ws + WS_XN), (const pg8::bf16_t*)(ws + WS_WFF1) + (size_t)sub * NFF1 * DM, MTOK, NFF1, DM};
            pg8::StaticOrder S; S.init(MTOK, NFF1, F.G, F.bx);
            pg8::EpiPair<1> E{(pg8::bf16_t*)(ws + WS_R1), FFN, 0};
            if (EN_UP) pg8::gemm_phase(F.lds, g, S, E, F.tid);
        } break;
        case K_FFN_DOWN: case K_WO: {
            CArgs& A = *get_args(); unsigned char* const ws = A.ws;
            const bool wo = (kind == K_WO);
            const pg8::bf16_t* R1 = (const pg8::bf16_t*)(ws + WS_R1);
            pg8::Gemm g{wo ? R1 + U_MG : R1, wo ? (const pg8::bf16_t*)(ws + WS_WO) : (const pg8::bf16_t*)(ws + WS_WFF2) + (size_t)sub * DM * FFN, MTOK, DM, wo ? DM : FFN};
            pg8::StaticOrder S; S.init(MTOK, DM, F.G, F.bx);
            const bool first = (!wo && l == 0 && sub == 0);
            const int gj = wo ? 5 : (sub == 0 ? 2 : 8);
            float* outp = A.out;
            const float* mod = (const float*)(ws + WS_MOD);
            pg8::EpiResid E{first ? A.in[I_XP] : outp, first ? A.in[I_XS] : outp + (size_t)MCTX * DM, outp, mod + (size_t)l * 9216 + gj * 1024, 2 * 9216, wo ? 1.0f : 0.5f};
            if (EN_DOWN) pg8::gemm_phase(F.lds, g, S, E, F.tid);
        } break;
        case K_WIN: {
            CArgs& A = *get_args(); unsigned char* const ws = A.ws;
            pg8::Gemm g{(const pg8::bf16_t*)(ws + WS_XN), (const pg8::bf16_t*)(ws + WS_WINM), MTOK, NINM, DM};
            pg8::StaticOrder S; S.init(MTOK, NINM, F.G, F.bx);
            pg8::EpiWin E{(pg8::bf16_t*)(ws + WS_R1)};
            if (EN_WIN) pg8::gemm_phase(F.lds, g, S, E, F.tid);
        } break;
        case K_MIX1: { if (EN_MIX1) { qk_pass(F, l); conv_pass(F, l); ret_pass1(F, l); } } break;
        case K_SCAN: { ret_scan(F, l); } break;
        case K_MIX2: { if (EN_RET3) ret_pass3(F, l); if (EN_ATTN) attn_naive(F, l); } break;
        case K_MERGE: {
            for (int b = 0; b < 3; ++b) {
                { CArgs& A = *get_args(); unsigned char* const ws = A.ws;
                  pg8::Gemm g{(const pg8::bf16_t*)(ws + WS_XN), (const pg8::bf16_t*)(ws + WS_WG) + (size_t)b * DM * DM, MTOK, DM, DM};
                  pg8::StaticOrder S; S.init(MTOK, DM, F.G, F.bx);
                  pg8::EpiSig E{(pg8::bf16_t*)(ws + WS_GS), nullptr};
                  if (EN_SIG) pg8::gemm_phase(F.lds, g, S, E, F.tid); }
                { CArgs& A = *get_args(); unsigned char* const ws = A.ws;
                  pg8::bf16_t* R1 = (pg8::bf16_t*)(ws + WS_R1);
                  const pg8::bf16_t* Ab = R1 + (b == 0 ? U_RQ : (b == 1 ? U_AQ : U_CB));
                  pg8::Gemm g{Ab, (const pg8::bf16_t*)(ws + WS_WRO) + (size_t)b * DM * 512, MTOK, DM, 512};
                  pg8::StaticOrder S; S.init(MTOK, DM, F.G, F.bx);
                  pg8::EpiMerge E{(const pg8::bf16_t*)(ws + WS_GS), (float*)(ws + WS_T), R1 + U_MG, b};
                  if (EN_MERGE) pg8::gemm_phase(F.lds, g, S, E, F.tid); }
            }
        } break;
        case K_XLAYER: { if (l == 0) { convert_weights(F, 1); modnorm_rows(F, 1, 0, false); } } break;
#if DBG
        case 98: { const int b = sub >> 1;
            if ((sub & 1) == 0) { CArgs& A = *get_args(); unsigned char* const ws = A.ws;
                  pg8::Gemm g{(const pg8::bf16_t*)(ws + WS_XN), (const pg8::bf16_t*)(ws + WS_WG) + (size_t)b * DM * DM, MTOK, DM, DM};
                  pg8::StaticOrder S; S.init(MTOK, DM, F.G, F.bx);
                  pg8::EpiSig E{(pg8::bf16_t*)(ws + WS_GS), (float*)(ws + WS_T)};
                  pg8::gemm_phase(F.lds, g, S, E, F.tid); }
            else { CArgs& A = *get_args(); unsigned char* const ws = A.ws;
                  pg8::bf16_t* R1 = (pg8::bf16_t*)(ws + WS_R1);
                  const pg8::bf16_t* Ab = R1 + (b == 0 ? U_RQ : (b == 1 ? U_AQ : U_CB));
                  pg8::Gemm g{Ab, (const pg8::bf16_t*)(ws + WS_WRO) + (size_t)b * DM * 512, MTOK, DM, 512};
                  pg8::StaticOrder S; S.init(MTOK, DM, F.G, F.bx);
                  pg8::EpiMerge E{(const pg8::bf16_t*)(ws + WS_GS), (float*)(ws + WS_T), R1 + U_MG, b};
                  pg8::gemm_phase(F.lds, g, S, E, F.tid); }
        } break;
        case 99: { if (sub == 999) dbg_final(F); else dbg_checks(F, sub); } break;
#endif
        default: break;
        }
        if (ph + 1 < ph_hi) {
            CArgs* A2 = get_args();
            unsigned bxx = bar_x; asm volatile("" : "+s"(bxx));
            XcdBarrier bar; bar.bar = (unsigned*)(A2->ws + WS_CTL) + CW_BAR; bar.x = bxx; bar.st = (volatile LAS unsigned*)(F.lds + MISC_OFF) + 8;
            xcd_barrier(bar, F.tid);
        }
    }
}

extern "C" void kernel_launch(void* const* d_in, const int* in_sizes, int n_in, void* d_out, int out_size, void* d_ws, size_t ws_size, hipStream_t stream) {
    static int grid = 0;
    if (grid == 0) {
        if (n_in != 22 || out_size != OUT_TOTAL || ws_size < WS_END) { fprintf(stderr, "kernel_launch: unexpected shapes: n_in %d out %d ws %zu (need %zu)\n", n_in, out_size, ws_size, (size_t)WS_END); grid = -1; return; }
        int dev = 0, cus = 0;
        if (hipGetDevice(&dev) != hipSuccess || hipDeviceGetAttribute(&cus, hipDeviceAttributeMultiprocessorCount, dev) != hipSuccess) { grid = -1; return; }
        if (hipFuncSetAttribute((const void*)trunk_fwd, hipFuncAttributeMaxDynamicSharedMemorySize, LDS_BYTES) != hipSuccess) { fprintf(stderr, "kernel_launch: hipFuncSetAttribute failed\n"); grid = -1; return; }
        int per_cu = 0;
        if (hipOccupancyMaxActiveBlocksPerMultiprocessor(&per_cu, (const void*)trunk_fwd, NWAVES * 64, LDS_BYTES) != hipSuccess || per_cu < 1) fprintf(stderr, "kernel_launch: occupancy query says %d\n", per_cu);
        (void)hipGetLastError();
        grid = cus;
    }
    if (grid < 0) return;
    (void)hipMemsetAsync((char*)d_ws + WS_CTL, 0, CTL_ZERO_BYTES, stream);
    Args a{};
    for (int i = 0; i < 22; ++i) a.in[i] = (const float*)d_in[i];
    a.out = (float*)d_out; a.ws = (unsigned char*)d_ws;
#if MK_MULTI_LAUNCH
    for (int ph = 0; ph < N_PHASES; ++ph) {
#if DBG
        if (0) { a.ph_lo = 1041; a.ph_hi = a.ph_lo + 1; hipLaunchKernelGGL(trunk_fwd, dim3(grid), dim3(NWAVES * 64), LDS_BYTES, stream, a); }
        if (0) { a.ph_lo = 1030 + (ph == 9 ? 1 : 0); a.ph_hi = a.ph_lo + 1; hipLaunchKernelGGL(trunk_fwd, dim3(grid), dim3(NWAVES * 64), LDS_BYTES, stream, a); }
        if (ph == 9) { for (int st = 0; st < 6; ++st) { a.ph_lo = 3000 + st; a.ph_hi = a.ph_lo + 1; hipLaunchKernelGGL(trunk_fwd, dim3(grid), dim3(NWAVES * 64), LDS_BYTES, stream, a);
                if (st == 0) { a.ph_lo = 1040; a.ph_hi = a.ph_lo + 1; hipLaunchKernelGGL(trunk_fwd, dim3(grid), dim3(NWAVES * 64), LDS_BYTES, stream, a); } } continue; }
#endif
        a.ph_lo = ph; a.ph_hi = ph + 1; hipLaunchKernelGGL(trunk_fwd, dim3(grid), dim3(NWAVES * 64), LDS_BYTES, stream, a);
#if DBG
        static const int after[][2] = {{8, 0}, {8, 1}, {9, 2}, {9, 3}, {10, 4}, {11, 5}, {12, 6}, {12, 3}, {13, 7}, {14, 16 + 9}, {15, 16 + 10}, {18, 16 + 8}, {21, 16 + 0}, {21, 16 + 1}};
        { static const int aft[][2] = {{5, 8}, {8, 0}, {8, 1}, {9, 2}, {9, 3}, {10, 4}};
          for (unsigned c = 0; c < 0; ++c) if (aft[c][0] == ph) { a.ph_lo = 1000 + aft[c][1]; a.ph_hi = a.ph_lo + 1; hipLaunchKernelGGL(trunk_fwd, dim3(grid), dim3(NWAVES * 64), LDS_BYTES, stream, a); } }
        if (0) { a.ph_lo = 1011; a.ph_hi = 1012; hipLaunchKernelGGL(trunk_fwd, dim3(grid), dim3(NWAVES * 64), LDS_BYTES, stream, a); a.ph_lo = 1012; a.ph_hi = 1013; hipLaunchKernelGGL(trunk_fwd, dim3(grid), dim3(NWAVES * 64), LDS_BYTES, stream, a); }
        for (unsigned c = 0; c < 0 * sizeof(after) / sizeof(after[0]); ++c) if (after[c][0] == ph) { a.ph_lo = 1000 + after[c][1]; a.ph_hi = a.ph_lo + 1; hipLaunchKernelGGL(trunk_fwd, dim3(grid), dim3(NWAVES * 64), LDS_BYTES, stream, a); }
#endif
    }
#if DBG
    a.ph_lo = 1999; a.ph_hi = 2000; hipLaunchKernelGGL(trunk_fwd, dim3(grid), dim3(NWAVES * 64), LDS_BYTES, stream, a);
#endif
#else
    a.ph_lo = 0; a.ph_hi = N_PHASES;
    hipLaunchKernelGGL(trunk_fwd, dim3(grid), dim3(NWAVES * 64), LDS_BYTES, stream, a);
#endif
}
```

```cpp
#include <hip/hip_runtime.h>
#include <cstdio>
#include <cstdint>

#ifndef EN_UP
#define EN_UP 1
#endif
#ifndef EN_DOWN
#define EN_DOWN 1
#endif
#ifndef EN_WIN
#define EN_WIN 1
#endif
#ifndef EN_SIG
#define EN_SIG 1
#endif
#ifndef EN_MERGE
#define EN_MERGE 1
#endif
#ifndef EN_MIX1
#define EN_MIX1 1
#endif
#ifndef EN_RET3
#define EN_RET3 1
#endif
#ifndef EN_ATTN
#define EN_ATTN 1
#endif
#ifndef EN_PRO
#define EN_PRO 1
#endif
#ifndef TPROBE
#define TPROBE 0
#endif
#ifndef MK_MULTI_LAUNCH
#define MK_MULTI_LAUNCH 0
#endif

namespace pg8 {
#define PG8_LAS __attribute__((address_space(3)))
typedef unsigned short bf16_t;
typedef short bf16x8 __attribute__((ext_vector_type(8)));
typedef float f32x4 __attribute__((ext_vector_type(4)));
typedef unsigned u32x4 __attribute__((ext_vector_type(4)));
constexpr int BM = 256, BK = 64, HALF = 128, HTB = HALF * BK * 2, STAGE_BYTES = 8 * HTB, NXCD = 8, WGM = 8;

__host__ __device__ __forceinline__ int lds_byte(int r, int c) { const int st = (r >> 4) * 2 + (c >> 5), rr = r & 15, cc = c & 31, ob = rr * 64 + cc * 2; return st * 1024 + (ob ^ (((ob >> 9) & 1) << 5)); }
__host__ __device__ __forceinline__ void stage_rc(int b, int& R, int& C) { const int st = b / 1024, sb = b % 1024, swz = sb ^ (((sb >> 9) & 1) << 5); R = (st >> 1) * 16 + swz / 64; C = (st & 1) * 32 + (swz % 64) / 2; }
__host__ __device__ __forceinline__ int perm32(int rho) { const int n = rho >> 4, i = rho & 15; return 8 * (i >> 2) + 4 * n + (i & 3); }

struct Unit { int pm, pn; };
struct Gemm { const bf16_t* A; const bf16_t* Bt; int M, N, K; };

struct StaticOrder {
    int nM, nN, nwg, G, c;
    __host__ __device__ void init(int M, int N, int G_, int c_) { nM = M / BM; nN = N / BM; nwg = nM * nN; G = G_; c = c_; }
    __host__ __device__ bool next(int i, Unit& u) const {
        const long L = (long)i * G + c; if (L >= nwg) return false;
        int wgid = (int)L; { const int q = nwg / NXCD, r = nwg % NXCD, xcd = wgid % NXCD, off = wgid / NXCD; wgid = (xcd < r ? xcd * (q + 1) : r * (q + 1) + (xcd - r) * q) + off; }
        const int nig = WGM * nN, gid = wgid / nig, fm = gid * WGM, gsz = (nM - fm) < WGM ? (nM - fm) : WGM;
        u.pm = fm + ((wgid % nig) % gsz); u.pn = (wgid % nig) / gsz; return true;
    }
};

typedef float f32x2_t __attribute__((ext_vector_type(2))); typedef __bf16 bf16x2_t __attribute__((ext_vector_type(2)));
__device__ __forceinline__ unsigned cvt_pk_bf16(float lo, float hi) { f32x2_t v = {lo, hi}; bf16x2_t b = __builtin_convertvector(v, bf16x2_t); return __builtin_bit_cast(unsigned, b); }
__device__ __forceinline__ float sigmoid_f(float x) { return __builtin_amdgcn_rcpf(1.0f + __expf(-x)); }
__device__ __forceinline__ float silu_f(float x) { return x * sigmoid_f(x); }
__device__ __forceinline__ float bflo(unsigned w) { return __uint_as_float(w << 16); }
__device__ __forceinline__ float bfhi(unsigned w) { return __uint_as_float(w & 0xffff0000u); }

template <int ACT> struct EpiPair {
    static constexpr bool PERM = true;
    bf16_t* O; int ldo; int tile0;
    __device__ __forceinline__ void operator()(const f32x4 (&acc)[2][2][4][2], const Unit& u, int wr, int wc, int fr, int fq) const {
        const int row0 = u.pm * BM + wr * 64 + fr, col0 = (u.pn - tile0) * HALF + wc * 32 + 8 * fq;
#pragma unroll
        for (int ai = 0; ai < 2; ++ai)
#pragma unroll
            for (int m = 0; m < 4; ++m) {
                bf16_t* rowp = O + (size_t)(row0 + ai * HALF + m * 16) * ldo + col0;
                f32x4 g0 = acc[ai][0][m][0], g1 = acc[ai][0][m][1]; const f32x4 u0 = acc[ai][1][m][0], u1 = acc[ai][1][m][1];
                if (ACT == 1) {
#pragma unroll
                    for (int j = 0; j < 4; ++j) { g0[j] = silu_f(g0[j]); g1[j] = silu_f(g1[j]); }
                }
                g0 = g0 * u0; g1 = g1 * u1;
                u32x4 w; w.x = cvt_pk_bf16(g0[0], g0[1]); w.y = cvt_pk_bf16(g0[2], g0[3]); w.z = cvt_pk_bf16(g1[0], g1[1]); w.w = cvt_pk_bf16(g1[2], g1[3]);
                *(u32x4*)rowp = w;
            }
    }
};
struct EpiWin {
    static constexpr bool PERM = true;
    bf16_t* U;
    __device__ __forceinline__ void operator()(const f32x4 (&acc)[2][2][4][2], const Unit& u, int wr, int wc, int fr, int fq) const {
        const int pn = u.pn; const size_t MP = (size_t)16384 * 512;
        const int row0 = u.pm * BM + wr * 64 + fr;
        if (pn >= 13) {
            EpiPair<0> e{U + 5 * MP + (size_t)16384 * 256 + MP, 512, 13}; e(acc, u, wr, wc, fr, fq); return;
        }
        bf16_t* base; int ld = 512, ct;
        if (pn < 10) { base = U + (size_t)(pn >> 1) * MP; ct = (pn & 1) * 256; }
        else if (pn == 10) { base = U + 5 * MP; ld = 256; ct = 0; }
        else { base = U + 5 * MP + (size_t)16384 * 256; ct = (pn - 11) * 256; }
        const bool do_silu = (pn == 6 || pn == 7);
        const int col0 = ct + wc * 32 + 8 * fq;
#pragma unroll
        for (int ai = 0; ai < 2; ++ai)
#pragma unroll
            for (int m = 0; m < 4; ++m) {
                bf16_t* rowp = base + (size_t)(row0 + ai * HALF + m * 16) * ld + col0;
#pragma unroll
                for (int bj = 0; bj < 2; ++bj) {
                    f32x4 v0 = acc[ai][bj][m][0], v1 = acc[ai][bj][m][1];
                    if (do_silu) {
#pragma unroll
                        for (int j = 0; j < 4; ++j) { v0[j] = silu_f(v0[j]); v1[j] = silu_f(v1[j]); }
                    }
                    u32x4 w; w.x = cvt_pk_bf16(v0[0], v0[1]); w.y = cvt_pk_bf16(v0[2], v0[3]); w.z = cvt_pk_bf16(v1[0], v1[1]); w.w = cvt_pk_bf16(v1[2], v1[3]);
                    *(u32x4*)(rowp + bj * HALF) = w;
                }
            }
    }
};
struct EpiResid {
    static constexpr bool PERM = false;
    const float* base_lo; const float* base_hi; float* out; const float* gate; int gate_stride; float gs;
    __device__ __forceinline__ void operator()(const f32x4 (&acc)[2][2][4][2], const Unit& u, int wr, int wc, int fr, int fq) const {
        const int col0 = u.pn * BM + wc * 32 + 4 * fq;
        const int ci = u.pm < 32 ? 0 : (u.pm < 48 ? 1 : 2);
        const float* gp = gate + (size_t)ci * gate_stride + col0;
        f32x4 gv[2][2];
#pragma unroll
        for (int bj = 0; bj < 2; ++bj)
#pragma unroll
            for (int n = 0; n < 2; ++n) gv[bj][n] = *(const f32x4*)(gp + bj * HALF + n * 16) * gs;
        const float* bb = u.pm < 32 ? base_lo + (size_t)u.pm * BM * 1024 : base_hi + (size_t)(u.pm - 32) * BM * 1024;
        float* oo = out + (size_t)u.pm * BM * 1024;
#pragma unroll
        for (int ai = 0; ai < 2; ++ai)
#pragma unroll
            for (int m = 0; m < 4; ++m) {
                const size_t off = (size_t)(ai * HALF + wr * 64 + m * 16 + fr) * 1024 + col0;
#pragma unroll
                for (int bj = 0; bj < 2; ++bj)
#pragma unroll
                    for (int n = 0; n < 2; ++n) {
                        const f32x4 b = *(const f32x4*)(bb + off + bj * HALF + n * 16);
                        *(f32x4*)(oo + off + bj * HALF + n * 16) = b + gv[bj][n] * acc[ai][bj][m][n];
                    }
            }
    }
};
struct EpiSig {
    static constexpr bool PERM = true;
    bf16_t* GS; float* DBGT;
    __device__ __forceinline__ void operator()(const f32x4 (&acc)[2][2][4][2], const Unit& u, int wr, int wc, int fr, int fq) const {
        const int row0 = u.pm * BM + wr * 64 + fr, col0 = u.pn * BM + wc * 32 + 8 * fq;
        if (DBGT) { float* p = DBGT + (size_t)(row0 + HALF + 48) * 1024 + col0 + HALF; *(f32x4*)p = acc[1][1][3][0]; *(f32x4*)(p + 4) = acc[1][1][3][1]; }
#pragma unroll
        for (int ai = 0; ai < 2; ++ai)
#pragma unroll
            for (int m = 0; m < 4; ++m) {
                bf16_t* rowp = GS + (size_t)(row0 + ai * HALF + m * 16) * 1024 + col0;
#pragma unroll
                for (int bj = 0; bj < 2; ++bj) {
                    f32x4 v0 = acc[ai][bj][m][0], v1 = acc[ai][bj][m][1];
#pragma unroll
                    for (int j = 0; j < 4; ++j) { v0[j] = sigmoid_f(v0[j]); v1[j] = sigmoid_f(v1[j]); }
                    u32x4 w; w.x = cvt_pk_bf16(v0[0], v0[1]); w.y = cvt_pk_bf16(v0[2], v0[3]); w.z = cvt_pk_bf16(v1[0], v1[1]); w.w = cvt_pk_bf16(v1[2], v1[3]);
                    *(u32x4*)(rowp + bj * HALF) = w;
                }
            }
    }
};
struct EpiMerge {
    static constexpr bool PERM = true;
    const bf16_t* GS; float* T; bf16_t* MG; int mode;
    __device__ __forceinline__ void operator()(const f32x4 (&acc)[2][2][4][2], const Unit& u, int wr, int wc, int fr, int fq) const {
        const int row0 = u.pm * BM + wr * 64 + fr, col0 = u.pn * BM + wc * 32 + 8 * fq;
#pragma unroll
        for (int ai = 0; ai < 2; ++ai)
#pragma unroll
            for (int m = 0; m < 4; ++m) {
                const size_t ro = (size_t)(row0 + ai * HALF + m * 16) * 1024 + col0;
#pragma unroll
                for (int bj = 0; bj < 2; ++bj) {
                    const u32x4 g = *(const u32x4*)(GS + ro + bj * HALF);
                    f32x4 v0 = acc[ai][bj][m][0], v1 = acc[ai][bj][m][1];
                    v0[0] *= bflo(g.x); v0[1] *= bfhi(g.x); v0[2] *= bflo(g.y); v0[3] *= bfhi(g.y);
                    v1[0] *= bflo(g.z); v1[1] *= bfhi(g.z); v1[2] *= bflo(g.w); v1[3] *= bfhi(g.w);
                    float* tp = T + ro + bj * HALF;
                    if (mode != 0) { v0 = v0 + *(const f32x4*)tp; v1 = v1 + *(const f32x4*)(tp + 4); }
                    if (mode != 2) { *(f32x4*)tp = v0; *(f32x4*)(tp + 4) = v1; }
                    else { u32x4 w; w.x = cvt_pk_bf16(v0[0], v0[1]); w.y = cvt_pk_bf16(v0[2], v0[3]); w.z = cvt_pk_bf16(v1[0], v1[1]); w.w = cvt_pk_bf16(v1[2], v1[3]);
                           *(u32x4*)(MG + ro + bj * HALF) = w; }
                }
            }
    }
};

template <class Epi, class Sched>
__device__ __forceinline__ void gemm_phase(PG8_LAS unsigned char* lds, const Gemm g, const Sched& S, const Epi& E, const int tid) {
    const int wid = __builtin_amdgcn_readfirstlane(tid >> 6), lane = tid & 63, wr = wid >> 2, wc = wid & 3, fr = lane & 15, fq = lane >> 4;
    const int K = g.K, nt = K / BK;
    unsigned voffA[2], voffB[2];
#pragma unroll
    for (int i = 0; i < 2; ++i) { int R, C; stage_rc(tid * 16 + i * 8192, R, C); const int Rb = Epi::PERM ? ((R & ~31) + perm32(R & 31)) : R;
        voffA[i] = (unsigned)(R * K + C) * 2u; voffB[i] = (unsigned)(Rb * K + C) * 2u; }
    const size_t kstep = (size_t)(BK * 2);
    const size_t hstep = (size_t)HALF * K * 2;
    const size_t tstep = 2 * hstep;
    const unsigned ldsw = (unsigned)wid * 1024u;
    const int aoff = lds_byte(wr * 64 + fr, fq * 8), boff = lds_byte(wc * 32 + fr, fq * 8);
#define PG8_SA(b, h) (((b) * 2 + (h)) * HTB)
#define PG8_SB(b, h) ((4 + (b) * 2 + (h)) * HTB)
#define PG8_STAGE(bufoff, gbase, voff) do { _Pragma("unroll") for (int _i = 0; _i < 2; ++_i) \
        __builtin_amdgcn_global_load_lds((const unsigned*)((const char*)(gbase) + (voff)[_i]), (PG8_LAS unsigned*)(lds + (bufoff) + ldsw + _i * 8192), 16, 0, 0); } while (0)
#define PG8_LDA(dst, b, h) do { _Pragma("unroll") for (int m = 0; m < 4; ++m) _Pragma("unroll") for (int k = 0; k < 2; ++k) dst[m][k] = *(const PG8_LAS bf16x8*)(lds + PG8_SA(b, h) + aoff + m * 2048 + k * 1024); } while (0)
#define PG8_LDB(dst, b, h) do { _Pragma("unroll") for (int n = 0; n < 2; ++n) _Pragma("unroll") for (int k = 0; k < 2; ++k) dst[n][k] = *(const PG8_LAS bf16x8*)(lds + PG8_SB(b, h) + boff + n * 2048 + k * 1024); } while (0)
#define PG8_MMA(ai, bj, At, Bt) do { __builtin_amdgcn_s_setprio(1); _Pragma("unroll") for (int m = 0; m < 4; ++m) _Pragma("unroll") for (int n = 0; n < 2; ++n) _Pragma("unroll") for (int k = 0; k < 2; ++k) \
        acc[ai][bj][m][n] = __builtin_amdgcn_mfma_f32_16x16x32_bf16(Bt[n][k], At[m][k], acc[ai][bj][m][n], 0, 0, 0); __builtin_amdgcn_s_setprio(0); } while (0)
#define PG8_WAIT_V(n) asm volatile("s_waitcnt vmcnt(" #n ")" ::: "memory")
#define PG8_WAIT_L(n) asm volatile("s_waitcnt lgkmcnt(" #n ")" ::: "memory")
#define PG8_BAR __builtin_amdgcn_s_barrier()
#define PG8_SCHED __builtin_amdgcn_sched_barrier(0)
    Unit cur, nxt; int ui = 0;
    if (!S.next(0, cur)) return;
    f32x4 acc[2][2][4][2];
#pragma unroll
    for (int a = 0; a < 2; ++a)
#pragma unroll
        for (int b = 0; b < 2; ++b)
#pragma unroll
            for (int m = 0; m < 4; ++m)
#pragma unroll
                for (int n = 0; n < 2; ++n) acc[a][b][m][n] = (f32x4){0.f, 0.f, 0.f, 0.f};
    bf16x8 At[4][2], B0[2][2], B1[2][2];
    const char* cA = (const char*)g.A + (size_t)cur.pm * tstep; const char* cB = (const char*)g.Bt + (size_t)cur.pn * tstep;
    PG8_STAGE(PG8_SB(0, 0), cB, voffB); PG8_STAGE(PG8_SB(0, 1), cB + hstep, voffB); PG8_STAGE(PG8_SA(0, 0), cA, voffA); PG8_STAGE(PG8_SA(0, 1), cA + hstep, voffA);
    if (wr == 1) PG8_BAR;
    PG8_WAIT_V(2); PG8_BAR;
    PG8_STAGE(PG8_SB(1, 0), cB + kstep, voffB); PG8_STAGE(PG8_SA(1, 0), cA + kstep, voffA); PG8_STAGE(PG8_SB(1, 1), cB + hstep + kstep, voffB);
    PG8_WAIT_V(6); PG8_BAR;
    for (;;) {
        const bool has_next = S.next(ui + 1, nxt);
        const char* nA = has_next ? (const char*)g.A + (size_t)nxt.pm * tstep : cA; const char* nB = has_next ? (const char*)g.Bt + (size_t)nxt.pn * tstep : cB;
        for (int t = 0; t < nt; t += 2) {
            const bool last = (t == nt - 2);
            const char* a1 = cA + (size_t)(t + 1) * kstep;
            const char* a2 = last ? nA : cA + (size_t)(t + 2) * kstep; const char* b2 = last ? nB : cB + (size_t)(t + 2) * kstep;
            const char* a3 = a2 + kstep; const char* b3 = b2 + kstep;
            PG8_LDB(B0, 0, 0); PG8_LDB(B1, 0, 1); PG8_SCHED; PG8_LDA(At, 0, 0); PG8_STAGE(PG8_SA(1, 1), a1 + hstep, voffA);
            PG8_WAIT_V(8); PG8_WAIT_L(0); PG8_BAR; PG8_MMA(0, 0, At, B0); PG8_MMA(0, 1, At, B1); PG8_BAR; PG8_SCHED;
            PG8_LDA(At, 0, 1); PG8_STAGE(PG8_SB(0, 0), b2, voffB); PG8_STAGE(PG8_SB(0, 1), b2 + hstep, voffB); PG8_STAGE(PG8_SA(0, 0), a2, voffA);
            PG8_WAIT_V(8); PG8_WAIT_L(0); PG8_BAR; PG8_MMA(1, 0, At, B0); PG8_MMA(1, 1, At, B1); PG8_BAR; PG8_SCHED;
            PG8_LDB(B0, 1, 0); PG8_LDB(B1, 1, 1); PG8_SCHED; PG8_LDA(At, 1, 0); PG8_STAGE(PG8_SA(0, 1), a2 + hstep, voffA);
            PG8_WAIT_V(8); PG8_WAIT_L(0); PG8_BAR; PG8_MMA(0, 0, At, B0); PG8_MMA(0, 1, At, B1); PG8_BAR; PG8_SCHED;
            PG8_LDA(At, 1, 1); PG8_STAGE(PG8_SB(1, 0), b3, voffB); PG8_STAGE(PG8_SB(1, 1), b3 + hstep, voffB); PG8_STAGE(PG8_SA(1, 0), a3, voffA);
            PG8_WAIT_V(8); PG8_WAIT_L(0); PG8_BAR; PG8_MMA(1, 0, At, B0); PG8_MMA(1, 1, At, B1); PG8_BAR; PG8_SCHED;
        }
        if (wr == 0) PG8_BAR;
        E(acc, cur, wr, wc, fr, fq);
        if (!has_next) break;
#pragma unroll
        for (int a = 0; a < 2; ++a)
#pragma unroll
            for (int b = 0; b < 2; ++b)
#pragma unroll
                for (int m = 0; m < 4; ++m)
#pragma unroll
                    for (int n = 0; n < 2; ++n) acc[a][b][m][n] = (f32x4){0.f, 0.f, 0.f, 0.f};
        cur = nxt; cA = nA; cB = nB; ++ui;
        if (wr == 1) PG8_BAR;
    }
    PG8_WAIT_V(0);
    PG8_BAR;
#undef PG8_SA
#undef PG8_SB
#undef PG8_STAGE
#undef PG8_LDA
#undef PG8_LDB
#undef PG8_MMA
#undef PG8_WAIT_V
#undef PG8_WAIT_L
#undef PG8_BAR
#undef PG8_SCHED
}
}

#include <hip/hip_bf16.h>
#include <cmath>
namespace attn_body {
using bf16=__hip_bfloat16;
using bf16x8=__attribute__((ext_vector_type(8)))short;
using s16x4=__attribute__((ext_vector_type(4)))short;
using f32x16=__attribute__((ext_vector_type(16)))float;
using u32x4=__attribute__((ext_vector_type(4)))unsigned;
constexpr int D=64,QP=512,KP=64;
constexpr int NW=8,QBLK=32,QB=QBLK*NW,KVBLK=64;
constexpr int ATTN_UNIT_ROWS=QB;
__device__ __forceinline__ int crow(int r,int hi){return (r&3)+8*(r>>2)+4*hi;}
#define SBAR() __builtin_amdgcn_sched_barrier(0)
__device__ __forceinline__ void cmask(f32x16&p0,f32x16&p1,int jb,int qrel,int hi){
  const float NEG=-INFINITY; int kb=64*jb+4*hi;
  #pragma unroll
  for(int r=0;r<16;++r){int kv=kb+(r&3)+8*(r>>2); if(kv>qrel)p0[r]=NEG; if(kv+32>qrel)p1[r]=NEG;}
}

constexpr int NSLOT=3, SLOTB=8192;
constexpr int LDS_K=0, LDS_V=NSLOT*SLOTB, LDS_WS=2*NSLOT*SLOTB, LDS_OST=LDS_WS+NW*64*4, LDS_BYTES=LDS_OST+NW*4096;
constexpr float C2=0.125f*1.4426950408889634f;
__device__ __forceinline__ void glds16(const void*gsrc,unsigned lds_dst){unsigned keep;
  asm volatile("s_mov_b32 %0, m0\n\ts_mov_b32 m0, %2\n\ts_nop 0\n\tglobal_load_lds_dwordx4 %1, off\n\ts_mov_b32 m0, %0":"=&s"(keep):"v"(gsrc),"s"(lds_dst):"memory");}
__device__ __forceinline__ float max3f(float a,float b,float c){float r;asm("v_max3_f32 %0, %1, %2, %3":"=v"(r):"v"(a),"v"(b),"v"(c));return r;}
__device__ __forceinline__ float max2f(float a,float b){float r;asm("v_max_f32_e32 %0, %1, %2":"=v"(r):"v"(a),"v"(b));return r;}
__device__ __forceinline__ float fadd_s(float a,float b){float r;asm("v_add_f32_e32 %0, %1, %2":"=v"(r):"v"(a),"v"(b));return r;}
__device__ __forceinline__ float fsub_s(float a,float b){float r;asm("v_sub_f32_e32 %0, %1, %2":"=v"(r):"v"(a),"v"(b));return r;}
typedef float f32x2_t __attribute__((ext_vector_type(2))); typedef __bf16 bf16x2_t __attribute__((ext_vector_type(2)));
__device__ __forceinline__ unsigned cvtpk_s(float lo,float hi){f32x2_t v={lo,hi};bf16x2_t b=__builtin_convertvector(v,bf16x2_t);return __builtin_bit_cast(unsigned,b);}
#define WAIT_BAR(N) asm volatile("s_waitcnt vmcnt(" #N ") lgkmcnt(0)\n\ts_barrier":::"memory")

__device__ __forceinline__ void qkt(f32x16&p0,f32x16&p1,const char*Kslot,const bf16x8*qr,const f32x16&negm,int r32,int hi){
  const char*kb=Kslot+hi*1024+r32*16;
  #pragma unroll
  for(int d0=0;d0<4;++d0){
    const bf16x8 b0=*reinterpret_cast<const bf16x8*>(kb+d0*2048);
    const bf16x8 b1=*reinterpret_cast<const bf16x8*>(kb+d0*2048+512);
    if(d0==0){p0=__builtin_amdgcn_mfma_f32_32x32x16_bf16(b0,qr[0],negm,0,0,0);p1=__builtin_amdgcn_mfma_f32_32x32x16_bf16(b1,qr[0],negm,0,0,0);}
    else{p0=__builtin_amdgcn_mfma_f32_32x32x16_bf16(b0,qr[d0],p0,0,0,0);p1=__builtin_amdgcn_mfma_f32_32x32x16_bf16(b1,qr[d0],p1,0,0,0);}}
}
typedef __attribute__((address_space(3))) const char* lds_cptr;
typedef short v4i16_t __attribute__((ext_vector_type(4)));
__device__ __forceinline__ void kload8(bf16x8*kf,lds_cptr kp){
  kf[0]=*(const __attribute__((address_space(3))) bf16x8*)(kp);      kf[1]=*(const __attribute__((address_space(3))) bf16x8*)(kp+512);
  kf[2]=*(const __attribute__((address_space(3))) bf16x8*)(kp+2048); kf[3]=*(const __attribute__((address_space(3))) bf16x8*)(kp+2560);
  kf[4]=*(const __attribute__((address_space(3))) bf16x8*)(kp+4096); kf[5]=*(const __attribute__((address_space(3))) bf16x8*)(kp+4608);
  kf[6]=*(const __attribute__((address_space(3))) bf16x8*)(kp+6144); kf[7]=*(const __attribute__((address_space(3))) bf16x8*)(kp+6656);
}
__device__ __forceinline__ void kload2(bf16x8*kf,lds_cptr kp,int j){ kf[2*j]=*(const __attribute__((address_space(3))) bf16x8*)(kp+j*2048); kf[2*j+1]=*(const __attribute__((address_space(3))) bf16x8*)(kp+j*2048+512); }
__device__ __forceinline__ s16x4 vtr(lds_cptr p){ return __builtin_bit_cast(s16x4,__builtin_amdgcn_ds_read_tr16_b64_v4i16((__attribute__((address_space(3))) v4i16_t*)p)); }
__device__ __forceinline__ float rowmax(const f32x16&p0,const f32x16&p1){
  float a=max3f(p0[0],p0[1],p1[0]),b=max3f(p0[2],p0[3],p1[1]);a=max3f(a,p1[2],p1[3]);
  #pragma unroll
  for(int r=4;r<16;r+=4){a=max3f(a,p0[r],p0[r+1]);b=max3f(b,p0[r+2],p0[r+3]);a=max3f(a,p1[r],p1[r+1]);b=max3f(b,p1[r+2],p1[r+3]);}
  const float m=max2f(a,b);
  auto rr=__builtin_amdgcn_permlane32_swap(__float_as_uint(m),__float_as_uint(m),false,false);
  return max2f(__uint_as_float(rr[0]),__uint_as_float(rr[1]));
}
__device__ __forceinline__ void pv(f32x16*o,int vb,bf16x8 pa0,bf16x8 pa1,bf16x8 pa2,bf16x8 pa3){
  #pragma unroll
  for(int d0=0;d0<2;++d0){s16x4 lo[4],hi[4];
    #pragma unroll
    for(int ks=0;ks<4;++ks){
      asm volatile("ds_read_b64_tr_b16 %0,%1 offset:%c2":"=&v"(lo[ks]):"v"(vb),"i"(d0*4096+ks*1024):"memory");
      asm volatile("ds_read_b64_tr_b16 %0,%1 offset:%c2":"=&v"(hi[ks]):"v"(vb),"i"(d0*4096+ks*1024+512):"memory");}
    asm volatile("s_waitcnt lgkmcnt(0)":::"memory");SBAR();
    #define PK(k) (bf16x8){lo[k][0],lo[k][1],lo[k][2],lo[k][3],hi[k][0],hi[k][1],hi[k][2],hi[k][3]}
    o[d0]=__builtin_amdgcn_mfma_f32_32x32x16_bf16(pa0,PK(0),o[d0],0,0,0);
    o[d0]=__builtin_amdgcn_mfma_f32_32x32x16_bf16(pa1,PK(1),o[d0],0,0,0);
    o[d0]=__builtin_amdgcn_mfma_f32_32x32x16_bf16(pa2,PK(2),o[d0],0,0,0);
    o[d0]=__builtin_amdgcn_mfma_f32_32x32x16_bf16(pa3,PK(3),o[d0],0,0,0);
    #undef PK
  }
}

#ifndef ATTN_STORE16
#define ATTN_STORE16(p,v) (*(u32x4*)(p)=(v))
#endif
template<int THRL> __device__ __forceinline__ void attn_unit(const bf16*Qu,const bf16*__restrict__ Kh,const bf16*__restrict__ Vh,bf16*Ou,const int NT,char*shm,const int tid){
  const int lane=tid&63,r32=lane&31,hi=lane>>5; const int wid=__builtin_amdgcn_readfirstlane(tid>>6);
  const bf16*Qw=Qu+(long)(wid*QBLK)*QP;
  const unsigned lds0=(unsigned)(uintptr_t)shm;
  float*wsf=(float*)(shm+LDS_WS)+wid*64;
  const bf16*ksrc=Kh+(long)lane*KP+wid*8;
  const bf16*vsrc=Vh+(long)(16*(wid&3)+(lane>>2))*KP+(wid>>2)*32+(lane&3)*8;
  const unsigned kdst=lds0+LDS_K+wid*1024, vdst=lds0+LDS_V+wid*1024;
  #define DMA_K(t,slot) glds16(ksrc+(long)(t)*KVBLK*KP,(unsigned)__builtin_amdgcn_readfirstlane(kdst+(slot)))
  #define DMA_V(t,slot) glds16(vsrc+(long)(t)*KVBLK*KP,(unsigned)__builtin_amdgcn_readfirstlane(vdst+(slot)))
  const int vb0=(int)(lds0+LDS_V)+((lane>>4)&1)*32+(lane&3)*8+(4*hi+((lane&15)>>2))*64;
  const char*Kbase=shm+LDS_K; bf16x8 kf[8];
  const lds_cptr shm3=(lds_cptr)shm; const lds_cptr kp0=shm3+LDS_K+hi*1024+r32*16; const lds_cptr vp0=shm3+LDS_V+((lane>>4)&1)*32+(lane&3)*8+(4*hi+((lane&15)>>2))*64;
  DMA_K(0,0);DMA_V(0,0);DMA_K(1,SLOTB);
  bf16x8 qr[4];
  #pragma unroll
  for(int d0=0;d0<4;++d0)qr[d0]=*reinterpret_cast<const bf16x8*>(&Qw[(long)r32*QP+d0*16+hi*8]);
  float mhat=0.f,l_reg=0.f;f32x16 o[2];o[0]=f32x16{};o[1]=f32x16{};f32x16 negm=f32x16{};asm volatile("":"+v"(negm));
  #define CMASK(P0,P1,t) do{}while(0)
  bool resc=false;
  #define START(P0,P1) do{ const float rm=rowmax(P0,P1); resc=false; \
    { const float dl=rm; mhat=fadd_s(mhat,dl); \
      _Pragma("unroll") for(int r=0;r<16;++r){P0[r]=fsub_s(P0[r],dl);P1[r]=fsub_s(P1[r],dl);} \
      _Pragma("unroll") for(int r=0;r<16;++r)negm[r]=-mhat; asm volatile("":"+v"(negm)); } \
    _Pragma("unroll") for(int r=0;r<16;++r)P0[r]=__builtin_amdgcn_exp2f(P0[r]); }while(0)
  #define RESC() do{ if(resc){ asm volatile("s_waitcnt lgkmcnt(0)":::"memory"); \
      _Pragma("unroll") for(int d_=0;d_<2;++d_) _Pragma("unroll") for(int r=0;r<16;++r)o[d_][r]*=wsf[crow(r,hi)]; } }while(0)
  f32x16 pA0,pA1,pB0,pB1;
  int sl_prev=0,sl_cur=0,sl_next=SLOTB;
  #define ROT() do{sl_prev=sl_cur;sl_cur=sl_next;sl_next=(sl_next==(NSLOT-1)*SLOTB)?0:sl_next+SLOTB;}while(0)
  DMA_K(2,2*SLOTB);
  WAIT_BAR(3);
  qkt(pA0,pA1,Kbase,qr,negm,r32,hi);asm volatile("s_nop 15\n\ts_nop 7":"+v"(pA0),"+v"(pA1));CMASK(pA0,pA1,0);
  START(pA0,pA1);
  _Pragma("unroll") for(int r=0;r<16;++r)pA1[r]=__builtin_amdgcn_exp2f(pA1[r]);
  WAIT_BAR(0);
  DMA_K(3,0);DMA_V(1,SLOTB);
  ROT();
  kload8(kf,kp0+sl_cur);
  WAIT_BAR(2);
  s16x4 vlo[8],vhi[8]; u32x4 pw0,pw1,pw2,pw3;
  #define PKW(P,B) cvtpk_s(P[B],P[B+1])
  #define PAF(k) __builtin_bit_cast(bf16x8,pw##k)
  #define VFR(i) (bf16x8){vlo[i][0],vlo[i][1],vlo[i][2],vlo[i][3],vhi[i][0],vhi[i][1],vhi[i][2],vhi[i][3]}
  #define PIN(x) asm volatile("":"+v"(x))
  #define MX3(a,b,c) __builtin_fmaxf(__builtin_fmaxf((a),(b)),(c))
  #define GAPA(MF,A0,A1,A2,A3,W0,W1,PW) do{ MF; sacc+=A0; sacc+=A1; sacc+=A2; sacc+=A3; PIN(sacc); W0; W1; PIN(PW); SBAR(); }while(0)
  #define EX(v) __builtin_amdgcn_exp2f(v)
  #define GAPB(MF,X,B) do{ MF; X[B]=EX(X[B]); X[B+1]=EX(X[B+1]); X[B+2]=EX(X[B+2]); X[B+3]=EX(X[B+3]); PIN(X); SBAR(); }while(0)
  #define VRD(i) do{ vlo[i]=vtr(vp_+(((i)>>2)*4096+((i)&3)*1024)); vhi[i]=vtr(vp_+(((i)>>2)*4096+((i)&3)*1024+512)); }while(0)
  #define KRD(G,j) do{ if(G){ kload2(kf,kp0+sl_next,j); SBAR(); } }while(0)
  #define STEP(C0,C1,P0,P1,t,GK,GV,GL) do{ SBAR(); \
    const lds_cptr vp_=vp0+sl_prev; \
    VRD(0); SBAR(); float sacc=(P0[0]+P0[1]); \
    GAPA(C0=__builtin_amdgcn_mfma_f32_32x32x16_bf16(kf[0],qr[0],negm,0,0,0), P0[2],P0[3],P0[4],P0[5],     pw0[0]=PKW(P0,0), pw0[1]=PKW(P0,2), pw0); \
    VRD(4); SBAR(); GAPA(C1=__builtin_amdgcn_mfma_f32_32x32x16_bf16(kf[1],qr[0],negm,0,0,0), P0[6],P0[7],P0[8],P0[9],     pw0[2]=PKW(P0,4), pw0[3]=PKW(P0,6), pw0); \
    VRD(1); SBAR(); GAPA(C0=__builtin_amdgcn_mfma_f32_32x32x16_bf16(kf[2],qr[1],C0,0,0,0),   P0[10],P0[11],P0[12],P0[13], pw1[0]=PKW(P0,8), pw1[1]=PKW(P0,10), pw1); \
    VRD(5); SBAR(); GAPA(C1=__builtin_amdgcn_mfma_f32_32x32x16_bf16(kf[3],qr[1],C1,0,0,0),   P0[14],P0[15],P1[0],P1[1],   pw1[2]=PKW(P0,12),pw1[3]=PKW(P0,14), pw1); \
    VRD(2); SBAR(); GAPA(C0=__builtin_amdgcn_mfma_f32_32x32x16_bf16(kf[4],qr[2],C0,0,0,0),   P1[2],P1[3],P1[4],P1[5],     pw2[0]=PKW(P1,0), pw2[1]=PKW(P1,2), pw2); \
    VRD(6); SBAR(); GAPA(C1=__builtin_amdgcn_mfma_f32_32x32x16_bf16(kf[5],qr[2],C1,0,0,0),   P1[6],P1[7],P1[8],P1[9],     pw2[2]=PKW(P1,4), pw2[3]=PKW(P1,6), pw2); \
    VRD(3); SBAR(); GAPA(C0=__builtin_amdgcn_mfma_f32_32x32x16_bf16(kf[6],qr[3],C0,0,0,0),   P1[10],P1[11],P1[12],P1[13], pw3[0]=PKW(P1,8), pw3[1]=PKW(P1,10), pw3); \
    VRD(7); SBAR(); GAPA(C1=__builtin_amdgcn_mfma_f32_32x32x16_bf16(kf[7],qr[3],C1,0,0,0),   P1[14],P1[15],0.f,0.f,       pw3[2]=PKW(P1,12),pw3[3]=PKW(P1,14), pw3); \
    l_reg+=sacc; \
    if(GK){DMA_K((t)+3,sl_cur);} if(GV){DMA_V((t)+1,sl_next);} \
    CMASK(C0,C1,t); \
    { float a=MX3(C0[0],C0[1],C1[0]),b=MX3(C0[2],C0[3],C1[1]); a=MX3(a,C1[2],C1[3]); \
      _Pragma("unroll") for(int r=4;r<16;r+=4){a=MX3(a,C0[r],C0[r+1]);b=MX3(b,C0[r+2],C0[r+3]);a=MX3(a,C1[r],C1[r+1]);b=MX3(b,C1[r+2],C1[r+3]);} \
      float rm=__builtin_fmaxf(a,b); { auto rr=__builtin_amdgcn_permlane32_swap(__float_as_uint(rm),__float_as_uint(rm),false,false); rm=__builtin_fmaxf(__uint_as_float(rr[0]),__uint_as_float(rr[1])); } \
      resc=false; \
      if(__builtin_expect(__any(rm>(float)THRL),0)){ const float dl=__builtin_fmaxf(rm,0.f); mhat+=dl; \
        _Pragma("unroll") for(int r=0;r<16;++r){C0[r]-=dl;C1[r]-=dl;} \
        _Pragma("unroll") for(int r=0;r<16;++r)negm[r]=-mhat; asm volatile("":"+v"(negm)); \
        const float f=__builtin_amdgcn_exp2f(-dl); l_reg*=f; if(hi==0)wsf[r32]=f; resc=true; } } \
    SBAR(); \
    GAPB(o[0]=__builtin_amdgcn_mfma_f32_32x32x16_bf16(PAF(0),VFR(0),o[0],0,0,0), C0,0); \
    GAPB(o[1]=__builtin_amdgcn_mfma_f32_32x32x16_bf16(PAF(0),VFR(4),o[1],0,0,0), C0,4); \
    KRD(GL,0); GAPB(o[0]=__builtin_amdgcn_mfma_f32_32x32x16_bf16(PAF(1),VFR(1),o[0],0,0,0), C0,8); \
    KRD(GL,1); GAPB(o[1]=__builtin_amdgcn_mfma_f32_32x32x16_bf16(PAF(1),VFR(5),o[1],0,0,0), C0,12); \
    KRD(GL,2); GAPB(o[0]=__builtin_amdgcn_mfma_f32_32x32x16_bf16(PAF(2),VFR(2),o[0],0,0,0), C1,0); \
    KRD(GL,3); GAPB(o[1]=__builtin_amdgcn_mfma_f32_32x32x16_bf16(PAF(2),VFR(6),o[1],0,0,0), C1,4); \
    GAPB(o[0]=__builtin_amdgcn_mfma_f32_32x32x16_bf16(PAF(3),VFR(3),o[0],0,0,0), C1,8); \
    GAPB(o[1]=__builtin_amdgcn_mfma_f32_32x32x16_bf16(PAF(3),VFR(7),o[1],0,0,0), C1,12); \
    }while(0)
  int t=1;
  #undef CMASK
  #define CMASK(P0,P1,t) do{}while(0)
  for(;t+5<NT;t+=2){
    STEP(pB0,pB1,pA0,pA1,t,true,true,true);     WAIT_BAR(2); RESC(); ROT();
    STEP(pA0,pA1,pB0,pB1,t+1,true,true,true);   WAIT_BAR(2); RESC(); ROT();
  }
  #undef CMASK
  #define CMASK(P0,P1,t) do{}while(0)
  #define ENDW(tt) do{ if((tt)+3<NT){WAIT_BAR(2);} else if((tt)+2<NT){WAIT_BAR(1);} else {WAIT_BAR(0);} }while(0)
  for(;t+1<NT;t+=2){
    STEP(pB0,pB1,pA0,pA1,t,(t+3<NT),(t+1<NT),(t+1<NT));       ENDW(t);   RESC(); ROT();
    STEP(pA0,pA1,pB0,pB1,t+1,(t+4<NT),(t+2<NT),(t+2<NT));     ENDW(t+1); RESC(); ROT();
  }
  STEP(pB0,pB1,pA0,pA1,NT-1,false,false,false); RESC();
  { float sacc=pB0[0]+pB0[1]; _Pragma("unroll") for(int r=2;r<16;++r)sacc+=pB0[r]; _Pragma("unroll") for(int r=0;r<16;++r)sacc+=pB1[r]; l_reg+=sacc;
    pw0=(u32x4){PKW(pB0,0),PKW(pB0,2),PKW(pB0,4),PKW(pB0,6)};pw1=(u32x4){PKW(pB0,8),PKW(pB0,10),PKW(pB0,12),PKW(pB0,14)};pw2=(u32x4){PKW(pB1,0),PKW(pB1,2),PKW(pB1,4),PKW(pB1,6)};pw3=(u32x4){PKW(pB1,8),PKW(pB1,10),PKW(pB1,12),PKW(pB1,14)};
    SBAR(); pv(o,vb0+sl_cur,PAF(0),PAF(1),PAF(2),PAF(3)); }
  #undef PKW
  #undef PAF
  #undef VFR
  #undef PIN
  #undef MX3
  #undef GAPA
  #undef GAPB
  #undef EX
  #undef VRD
  #undef KRD
  #undef STEP
  #undef ENDW
  {auto rr=__builtin_amdgcn_permlane32_swap(__float_as_uint(l_reg),__float_as_uint(l_reg),false,false);l_reg=__uint_as_float(rr[0])+__uint_as_float(rr[1]);}
  if(hi==0)wsf[32+r32]=l_reg;asm volatile("s_waitcnt lgkmcnt(0)":::"memory");
  float rli[16];
  #pragma unroll
  for(int r=0;r<16;++r)rli[r]=__builtin_amdgcn_rcpf(wsf[32+crow(r,hi)]);
  bf16*Ow=Ou+(long)(wid*QBLK)*QP;
  { bf16*stg=(bf16*)(shm+LDS_OST)+wid*2048;
    #pragma unroll
    for(int r=0;r<16;++r){const int orow=crow(r,hi);
      #pragma unroll
      for(int d0=0;d0<2;++d0)stg[orow*64+d0*32+r32]=__float2bfloat16(o[d0][r]*rli[r]);}
    asm volatile("s_waitcnt lgkmcnt(0)":::"memory");
    #pragma unroll
    for(int i=0;i<4;++i){const int row=i*8+(lane>>3),ch=lane&7; const u32x4 v=*(const u32x4*)(stg+row*64+ch*8); ATTN_STORE16(Ow+(long)row*QP+ch*8,v);} }
  asm volatile("s_waitcnt lgkmcnt(0)\n\ts_barrier":::"memory");
  #undef DMA_K
  #undef DMA_V
  #undef CMASK
  #undef START
  #undef RESC
  #undef ROT
}
constexpr int ATTN_LDS_BYTES=LDS_BYTES;
#undef SBAR
#undef WAIT_BAR
}

constexpr int NWAVES = 8;
constexpr int DM = 1024, MTOK = 16384, MCTX = 8192, FFN = 2816, NFF1 = 5632, NINM = 4352, NGATE = 3072, NIN_SRC = 7424;
constexpr int DEPTH = 2, SEQC = 256, SEQL = 4096, PAST = 512, SKL = PAST + SEQL;
constexpr float EPS = 1e-6f;
constexpr int OUT_STATE = 16777216, OUT_CK = 25165824, OUT_CV = 27262976, OUT_TOTAL = 29360128;

constexpr size_t MiB = 1u << 20;
constexpr size_t WS_CTL = 0, CTL_ZERO_BYTES = 1 * MiB;
constexpr size_t WS_MOD = 1 * MiB;
constexpr size_t WS_ROPE = WS_MOD + 256 * 1024;
constexpr size_t WS_WFF1 = 2 * MiB;
constexpr size_t WS_WFF2 = 24 * MiB;
constexpr size_t WS_WINM = 35 * MiB;
constexpr size_t WS_WG = WS_WINM + 8 * MiB + 512 * 1024;
constexpr size_t WS_WRO = WS_WG + 6 * MiB;
constexpr size_t WS_WO = WS_WRO + 3 * MiB;
constexpr size_t WS_KL = 55 * MiB;
constexpr size_t WS_VL = WS_KL + 4 * MiB + 512 * 1024;
constexpr size_t WS_KC = WS_VL + 4 * MiB + 512 * 1024;
constexpr size_t WS_VC = WS_KC + 2 * MiB;
constexpr size_t WS_XN = 68 * MiB;
constexpr size_t WS_R1 = 100 * MiB;
constexpr size_t WS_GS = 220 * MiB;
constexpr size_t WS_T = 252 * MiB;
constexpr size_t WS_END = 316 * MiB;
constexpr size_t PLANE = (size_t)MTOK * 512;
constexpr size_t U_RQ = 0, U_RK = PLANE, U_RV = 2 * PLANE, U_SRG = 3 * PLANE, U_AQ = 4 * PLANE, U_AKV = 5 * PLANE, U_CB = 5 * PLANE + (size_t)MTOK * 256, U_P = U_CB + PLANE;
constexpr size_t U_MG = U_RK;
constexpr int CW_BAR = 4096;

constexpr int RING_BYTES = 131072, MISC_OFF = RING_BYTES + 320, LDS_BYTES = 147456;

#define GAS __attribute__((address_space(1)))
#define LAS __attribute__((address_space(3)))
typedef unsigned short bf16;
typedef unsigned v4u __attribute__((ext_vector_type(4)));
typedef float f32x4 __attribute__((ext_vector_type(4)));
#define RLX_AGENT __ATOMIC_RELAXED, __HIP_MEMORY_SCOPE_AGENT
__device__ __forceinline__ unsigned f2bf(float f) { unsigned u = __builtin_bit_cast(unsigned, f); return (u + 0x7fffu + ((u >> 16) & 1u)) >> 16; }
__device__ __forceinline__ unsigned pk2(float lo, float hi) { return f2bf(lo) | (f2bf(hi) << 16); }
__device__ __forceinline__ float bf2f(unsigned short h) { return __uint_as_float(((unsigned)h) << 16); }
__device__ __forceinline__ float blo(unsigned w) { return __uint_as_float(w << 16); }
__device__ __forceinline__ float bhi(unsigned w) { return __uint_as_float(w & 0xffff0000u); }
__device__ __forceinline__ float fexp2(float x) { return __builtin_amdgcn_exp2f(x); }
__device__ __forceinline__ float fexp(float x) { return __builtin_amdgcn_exp2f(x * 1.4426950408889634f); }
__device__ __forceinline__ float frsq(float x) { return __builtin_amdgcn_rsqf(x); }

#define XB_TMO      128
#define XB_XCNT(j)  (256  + 64 * (j))
#define XB_XSUB(j)  (1280 + 64 * (j))
#define XB_XGEN(j)  (2304 + 64 * (j))
#define XB_TOP      3328
#define XB_TOPGEN   3392
#define XCD_BAR_WORDS 3456
#define XB_SPIN_CAP (1u << 18)
__device__ __forceinline__ unsigned xb_ld(unsigned* p)              { return __hip_atomic_load(p, __ATOMIC_RELAXED, __HIP_MEMORY_SCOPE_AGENT); }
__device__ __forceinline__ unsigned xb_add(unsigned* p, unsigned v) { return __hip_atomic_fetch_add(p, v, __ATOMIC_RELAXED, __HIP_MEMORY_SCOPE_AGENT); }
__device__ __forceinline__ unsigned xb_xcc_id() { return (unsigned)__builtin_amdgcn_s_getreg((3 << 11) | 20) & 0xFu; }
#define XB_SPIN(cond, bar) do { unsigned _sp = 0; while (cond) { __builtin_amdgcn_s_sleep(1); \
    if ((++_sp & 255u) == 0u) { if (xb_ld(&(bar)[XB_TMO])) break; if (_sp > XB_SPIN_CAP) { atomicAdd(&(bar)[XB_TMO], 1u); break; } } } } while (0)
struct XcdBarrier { unsigned* bar; unsigned x; volatile LAS unsigned* st; };
__device__ __forceinline__ XcdBarrier xcd_barrier_post(unsigned* bar, volatile LAS unsigned* st) {
    XcdBarrier b; b.bar = bar; b.x = xb_xcc_id(); b.st = st;
    if (threadIdx.x == 0) (void)xb_add(&bar[XB_XCNT(b.x)], 1u);
    return b;
}
__device__ __forceinline__ void xcd_barrier_complete(unsigned* bar, unsigned x, unsigned& nloc, unsigned& nx) {
    const unsigned G = gridDim.x * gridDim.y * gridDim.z;
    unsigned sum, cnt, mine, sp = 0u;
    for (;;) {
        sum = 0u; cnt = 0u; mine = 0u;
#pragma unroll
        for (unsigned j = 0; j < 16; ++j) { const unsigned c = xb_ld(&bar[XB_XCNT(j)]); sum += c; cnt += (c > 0u) ? 1u : 0u; mine = (j == x) ? c : mine; }
        if (sum == G) break;
        __builtin_amdgcn_s_sleep(1);
        if ((++sp & 255u) == 0u) { if (xb_ld(&bar[XB_TMO])) break; if (sp > XB_SPIN_CAP) { atomicAdd(&bar[XB_TMO], 1u); break; } }
    }
    nloc = mine > 0u ? mine : 1u; nx = cnt > 0u ? cnt : 1u;
}
__device__ __forceinline__ void xcd_barrier(const XcdBarrier& b, const int tid) {
    asm volatile("s_waitcnt vmcnt(0)" ::: "memory");
    __syncthreads();
    if (tid == 0) {
        unsigned* bar = b.bar;
        __builtin_amdgcn_s_waitcnt(0);
        unsigned nloc = b.st[0], nx = b.st[1];
        if (nloc == 0u) { xcd_barrier_complete(bar, b.x, nloc, nx); b.st[0] = nloc; b.st[1] = nx; }
        const unsigned old = xb_add(&bar[XB_XSUB(b.x)], 1u);
        const unsigned gen = old / nloc;
        if (old + 1u == (gen + 1u) * nloc) {
            __builtin_amdgcn_fence(__ATOMIC_RELEASE, "agent");
            asm volatile("s_waitcnt vmcnt(0)" ::: "memory");
            const unsigned og = xb_add(&bar[XB_TOP], 1u);
            const unsigned tg = og / nx;
            if (og + 1u == (tg + 1u) * nx) xb_add(&bar[XB_TOPGEN], 1u);
            else XB_SPIN(xb_ld(&bar[XB_TOPGEN]) == tg, bar);
            __builtin_amdgcn_fence(__ATOMIC_ACQUIRE, "agent");
            xb_add(&bar[XB_XGEN(b.x)], 1u);
            asm volatile("s_waitcnt vmcnt(0)" ::: "memory");
        } else {
            XB_SPIN(xb_ld(&bar[XB_XGEN(b.x)]) == gen, bar);
            __builtin_amdgcn_fence(__ATOMIC_ACQUIRE, "agent");
            asm volatile("s_waitcnt vmcnt(0)" ::: "memory");
        }
    }
    __syncthreads();
}

struct Args { const float* in[22]; float* out; unsigned char* ws; int ph_lo, ph_hi; };
enum { I_XP = 0, I_XS, I_C, I_STATE, I_CK, I_CV, I_CCTX, I_WADA, I_BADA, I_NORMW, I_WFFIN, I_WFFOUT, I_WIN, I_DECAY, I_RETGN, I_QG, I_KG, I_CONVW, I_WRO, I_WAO, I_WCO, I_WO };

typedef const Args __attribute__((address_space(4))) CArgs;
__device__ __forceinline__ CArgs* get_args() { CArgs* p = (CArgs*)__builtin_amdgcn_kernarg_segment_ptr(); asm volatile("" : "+s"(p)); return p; }
struct Frame {
    LAS unsigned char* lds;
    int tid, lane, wave, vcu, G, bx;
};
__device__ __forceinline__ int cond_of_row(int m) { return m < MCTX ? 0 : (m < MCTX + SEQL ? 1 : 2); }
__device__ __forceinline__ float wave_sum(float v) {
#pragma unroll
    for (int o = 1; o < 64; o <<= 1) v += __shfl_xor(v, o);
    return v;
}

__device__ __forceinline__ void transpose_item(const float* W, int K, int srcN, int src_col0, bf16* WT, int dst_row0, int k0, LAS float* scr, int lane) {
#pragma unroll 8
    for (int i = 0; i < 32; ++i) { const int kk = 2 * i + (lane >> 5); scr[kk * 33 + (lane & 31)] = W[(size_t)(k0 + kk) * srcN + src_col0 + (lane & 31)]; }
    asm volatile("s_waitcnt lgkmcnt(0)" ::: "memory");
    const int c = lane & 7;
#pragma unroll
    for (int j = 0; j < 4; ++j) { const int n = (lane >> 3) + 8 * j; const LAS float* s = scr + (8 * c) * 33 + n;
        v4u o; o.x = pk2(s[0 * 33], s[1 * 33]); o.y = pk2(s[2 * 33], s[3 * 33]); o.z = pk2(s[4 * 33], s[5 * 33]); o.w = pk2(s[6 * 33], s[7 * 33]);
        *(GAS v4u*)(WT + (size_t)(dst_row0 + n) * K + k0 + 8 * c) = o; }
    asm volatile("s_waitcnt lgkmcnt(0)" ::: "memory");
}
__device__ __forceinline__ void convert_weights(Frame& F, int l) {
    LAS float* scr = (LAS float*)(F.lds + F.wave * 16384);
    const int gw = F.vcu * NWAVES + F.wave, NGW = F.G * NWAVES;
    CArgs& A = *get_args(); unsigned char* const WSP = A.ws;
    constexpr int I_FF1 = 16 * 176, I_FF2 = 44 * 32, I_INM = 16 * 136, I_GT = 16 * 96, I_BO = 8 * 32, I_OO = 16 * 32;
    constexpr int NITEMS = 2 * I_FF1 + 2 * I_FF2 + I_INM + I_GT + 3 * I_BO + I_OO;
    for (int it = gw; it < NITEMS; it += NGW) {
        int r = it;
        if (r < 2 * I_FF1) {
            const int f = r / I_FF1; r -= f * I_FF1; const int kb = r / 176, nb = r % 176, t = nb >> 3, q = nb & 7;
            const int sc = (q < 4) ? (128 * t + 32 * q) : (FFN + 128 * t + 32 * (q - 4));
            transpose_item(A.in[I_WFFIN] + (size_t)(l * 2 + f) * DM * NFF1, DM, NFF1, sc, (bf16*)(WSP + WS_WFF1) + (size_t)f * NFF1 * DM, 32 * nb, 64 * kb, scr, F.lane); continue; }
        r -= 2 * I_FF1;
        if (r < 2 * I_FF2) { const int f = r / I_FF2; r -= f * I_FF2; const int kb = r / 32, nb = r % 32;
            transpose_item(A.in[I_WFFOUT] + (size_t)(l * 2 + f) * FFN * DM, FFN, DM, 32 * nb, (bf16*)(WSP + WS_WFF2) + (size_t)f * DM * FFN, 32 * nb, 64 * kb, scr, F.lane); continue; }
        r -= 2 * I_FF2;
        if (r < I_INM) { const int kb = r / 136, nb = r % 136, t = nb >> 3, q = nb & 7;
            int sc; if (t < 13) sc = 32 * nb; else { const int i = t - 13; sc = (q < 4) ? (3328 + 128 * i + 32 * q) : (3840 + 128 * i + 32 * (q - 4)); }
            transpose_item(A.in[I_WIN] + (size_t)l * DM * NIN_SRC, DM, NIN_SRC, sc, (bf16*)(WSP + WS_WINM), 32 * nb, 64 * kb, scr, F.lane); continue; }
        r -= I_INM;
        if (r < I_GT) { const int kb = r / 96, nb = r % 96;
            transpose_item(A.in[I_WIN] + (size_t)l * DM * NIN_SRC, DM, NIN_SRC, NINM + 32 * nb, (bf16*)(WSP + WS_WG), 32 * nb, 64 * kb, scr, F.lane); continue; }
        r -= I_GT;
        if (r < 3 * I_BO) { const int b = r / I_BO; r -= b * I_BO; const int kb = r / 32, nb = r % 32;
            const float* src = (b == 0 ? A.in[I_WRO] : (b == 1 ? A.in[I_WAO] : A.in[I_WCO])) + (size_t)l * 512 * DM;
            transpose_item(src, 512, DM, 32 * nb, (bf16*)(WSP + WS_WRO) + (size_t)b * DM * 512, 32 * nb, 64 * kb, scr, F.lane); continue; }
        r -= 3 * I_BO;
        { const int kb = r / 32, nb = r % 32;
          transpose_item(A.in[I_WO] + (size_t)l * DM * DM, DM, DM, 32 * nb, (bf16*)(WSP + WS_WO), 32 * nb, 64 * kb, scr, F.lane); }
    }
}
__device__ __forceinline__ void compute_mod(Frame& F) {
    CArgs& A = *get_args(); unsigned char* const WSP = A.ws;
    LAS float* sc = (LAS float*)(F.lds);
    LAS float* red = sc + 3072;
    for (int i = F.tid; i < 3072; i += 512) { const int ci = i >> 10, k = i & 1023; const float c = (ci == 0) ? A.in[I_CCTX][k] : A.in[I_C][(ci - 1) * 1024 + k]; sc[i] = c * __builtin_amdgcn_rcpf(1.0f + fexp(-c)); }
    __syncthreads();
    float* mod = (float*)(WSP + WS_MOD);
    for (int item = F.bx; item < 288; item += F.G) {
        const int l = item / 144, n0 = (item % 144) * 64, col = F.tid & 63, kg = F.tid >> 6;
        const float* w = A.in[I_WADA] + (size_t)l * DM * 9216 + n0 + col;
        float a0 = 0.f, a1 = 0.f, a2 = 0.f;
#pragma unroll 8
        for (int kk = 0; kk < 128; ++kk) { const int k = kg * 128 + kk; const float wv = w[(size_t)k * 9216]; a0 += sc[k] * wv; a1 += sc[1024 + k] * wv; a2 += sc[2048 + k] * wv; }
        red[(kg * 3 + 0) * 64 + col] = a0; red[(kg * 3 + 1) * 64 + col] = a1; red[(kg * 3 + 2) * 64 + col] = a2;
        __syncthreads();
        if (F.tid < 192) { const int ci = F.tid >> 6, c = F.tid & 63; float s = A.in[I_BADA][l * 9216 + n0 + c];
#pragma unroll
            for (int g = 0; g < 8; ++g) s += red[(g * 3 + ci) * 64 + c];
            mod[(size_t)(ci * 2 + l) * 9216 + n0 + c] = s; }
        __syncthreads();
    }
}
__device__ __forceinline__ void prologue_misc(Frame& F) {
    CArgs& A = *get_args(); unsigned char* const WSP = A.ws;
    if (F.bx == F.G - 1) {
        float* ct = (float*)(WSP + WS_ROPE); float* st = ct + 1024;
        for (int i = F.tid; i < 1024; i += 512) { const int pos = i >> 4, fi = i & 15; const float inv = fexp2(-(float)fi * 0.8304820237218406f);
            const float rev = (float)pos * inv * 0.15915494309189535f; ct[i] = __builtin_amdgcn_cosf(rev); st[i] = __builtin_amdgcn_sinf(rev); }
    }
    const int gt = F.bx * 512 + F.tid, NT = F.G * 512;
    bf16* KL = (bf16*)(WSP + WS_KL); bf16* VL = (bf16*)(WSP + WS_VL);
    for (int i = gt; i < 2 * 2 * PAST * 128; i += NT) {
        const int d = i & 63, kv = (i >> 6) & 1, s = (i >> 7) & 511, l = (i >> 16) & 1, b = i >> 17;
        const size_t dst = ((size_t)((l * 2 + b) * 2 + kv) * SKL + s) * 64 + d;
        KL[dst] = (bf16)f2bf(A.in[I_CK][i]); VL[dst] = (bf16)f2bf(A.in[I_CV][i]);
    }
}
__device__ __forceinline__ void modnorm_rows(Frame& F, int l, int j, bool from_x) {
    CArgs& A = *get_args(); unsigned char* const WSP = A.ws;
    const int gw = F.vcu * NWAVES + F.wave, NGW = F.G * NWAVES;
    const float* mod = (const float*)(WSP + WS_MOD);
    bf16* XN = (bf16*)(WSP + WS_XN);
    const float* nw = A.in[I_NORMW] + (size_t)(l * 3 + j) * DM;
    for (int m = gw; m < MTOK; m += NGW) {
        const float* xrow = from_x ? (m < MCTX ? A.in[I_XP] + (size_t)m * DM : A.in[I_XS] + (size_t)(m - MCTX) * DM) : A.out + (size_t)m * DM;
        const int ci = cond_of_row(m);
        const float* sh = mod + (size_t)(ci * 2 + l) * 9216 + (3 * j) * 1024; const float* scl = sh + 1024;
        const f32x4* xr = (const f32x4*)xrow + F.lane;
        f32x4 v[4]; float s2 = 0.f;
#pragma unroll
        for (int q = 0; q < 4; ++q) { v[q] = xr[64 * q]; s2 += (v[q].x * v[q].x + v[q].y * v[q].y) + (v[q].z * v[q].z + v[q].w * v[q].w); }
        const float rstd = frsq(wave_sum(s2) * (1.0f / DM) + EPS);
        unsigned long long* o8 = (unsigned long long*)(XN + (size_t)m * DM) + F.lane;
#pragma unroll
        for (int q = 0; q < 4; ++q) {
            const f32x4 g = ((const f32x4*)nw)[F.lane + 64 * q], s = ((const f32x4*)scl)[F.lane + 64 * q], b = ((const f32x4*)sh)[F.lane + 64 * q];
            const f32x4 y = v[q] * rstd * g * (s + 1.0f) + b;
            o8[64 * q] = (unsigned long long)pk2(y.x, y.y) | ((unsigned long long)pk2(y.z, y.w) << 32);
        }
    }
}
__device__ __forceinline__ void qk_pass(Frame& F, int l) {
    CArgs& A = *get_args(); unsigned char* const WSP = A.ws;
    const int gw = F.vcu * NWAVES + F.wave, NGW = F.G * NWAVES, lane = F.lane;
    bf16* U = (bf16*)(WSP + WS_R1);
    const float* ct = (const float*)(WSP + WS_ROPE); const float* st = ct + 1024;
    const float* qg = A.in[I_QG] + l * 64; const float* kg = A.in[I_KG] + l * 64;
    const int d0 = (lane & 7) * 8;
    const float QS = 0.125f * 1.4426950408889634f;
    for (int m = gw; m < MTOK; m += NGW) {
        const bool lat = m >= MCTX; int trow = 0, tcol = 0;
        if (lat) { const int t = (m - MCTX) & (SEQL - 1); trow = t >> 6; tcol = t & 63; }
        float cs[8], sn[8];
#pragma unroll
        for (int e = 0; e < 8; ++e) { const int i = (d0 & 31) + e; const int idx = (i < 16) ? (trow * 16 + i) : (tcol * 16 + (i - 16)); cs[e] = ct[idx]; sn[e] = st[idx]; }
        {
            bf16* qp = U + U_AQ + (size_t)m * 512 + lane * 8;
            const v4u w = *(const v4u*)qp;
            float x[8] = {blo(w.x), bhi(w.x), blo(w.y), bhi(w.y), blo(w.z), bhi(w.z), blo(w.w), bhi(w.w)};
            float ss = 0.f;
#pragma unroll
            for (int e = 0; e < 8; ++e) ss += x[e] * x[e];
            ss += __shfl_xor(ss, 1); ss += __shfl_xor(ss, 2); ss += __shfl_xor(ss, 4);
            const float r = frsq(ss * (1.0f / 64.0f) + EPS);
#pragma unroll
            for (int e = 0; e < 8; ++e) x[e] = x[e] * r * qg[d0 + e];
            if (lat) {
#pragma unroll
                for (int e = 0; e < 8; ++e) { const float p = __shfl_xor(x[e], 4); x[e] = (d0 < 32) ? (x[e] * cs[e] - p * sn[e]) : (p * sn[e] + x[e] * cs[e]); }
            }
            v4u o; o.x = pk2(x[0] * QS, x[1] * QS); o.y = pk2(x[2] * QS, x[3] * QS); o.z = pk2(x[4] * QS, x[5] * QS); o.w = pk2(x[6] * QS, x[7] * QS);
            *(v4u*)qp = o;
        }
        {
            const int l2 = lane & 31;
            const v4u w = *(const v4u*)(U + U_AKV + (size_t)m * 256 + l2 * 8);
            float x[8] = {blo(w.x), bhi(w.x), blo(w.y), bhi(w.y), blo(w.z), bhi(w.z), blo(w.w), bhi(w.w)};
            const bool isk = l2 < 16;
            float ss = 0.f;
#pragma unroll
            for (int e = 0; e < 8; ++e) ss += x[e] * x[e];
            ss += __shfl_xor(ss, 1); ss += __shfl_xor(ss, 2); ss += __shfl_xor(ss, 4);
            const float r = frsq(ss * (1.0f / 64.0f) + EPS);
            if (isk) {
#pragma unroll
                for (int e = 0; e < 8; ++e) x[e] = x[e] * r * kg[d0 + e];
            }
            const int kv = (l2 >> 3) & 1;
            if (!lat) {
                const int b = m >> 8, t = m & 255;
                if (lane < 32) {
                    float* dst = A.out + (isk ? OUT_CK : OUT_CV) + ((size_t)((b * 2 + l) * 256 + t) * 2 + kv) * 64 + d0;
                    *(f32x4*)dst = (f32x4){x[0], x[1], x[2], x[3]}; *(f32x4*)(dst + 4) = (f32x4){x[4], x[5], x[6], x[7]};
                    bf16* kc = (bf16*)(WSP + (isk ? WS_KC : WS_VC)) + ((size_t)(b * 2 + kv) * 256 + t) * 64 + d0;
                    v4u o; o.x = pk2(x[0], x[1]); o.y = pk2(x[2], x[3]); o.z = pk2(x[4], x[5]); o.w = pk2(x[6], x[7]);
                    *(v4u*)kc = o;
                }
            } else {
                float y[8];
#pragma unroll
                for (int e = 0; e < 8; ++e) { const float p = __shfl_xor(x[e], 4); y[e] = (d0 < 32) ? (x[e] * cs[e] - p * sn[e]) : (p * sn[e] + x[e] * cs[e]); }
                if (lane < 32) {
                    const int b = (m - MCTX) >> 12, t = (m - MCTX) & (SEQL - 1);
                    bf16* kc = (bf16*)(WSP + (isk ? WS_KL : WS_VL)) + ((size_t)((l * 2 + b) * 2 + kv) * SKL + PAST + t) * 64 + d0;
                    v4u o;
                    if (isk) { o.x = pk2(y[0], y[1]); o.y = pk2(y[2], y[3]); o.z = pk2(y[4], y[5]); o.w = pk2(y[6], y[7]); }
                    else { o.x = pk2(x[0], x[1]); o.y = pk2(x[2], x[3]); o.z = pk2(x[4], x[5]); o.w = pk2(x[6], x[7]); }
                    *(v4u*)kc = o;
                }
            }
        }
    }
}
__device__ __forceinline__ void conv_pass(Frame& F, int l) {
    CArgs& A = *get_args(); unsigned char* const WSP = A.ws;
    const int gw = F.vcu * NWAVES + F.wave, NGW = F.G * NWAVES, lane = F.lane;
    bf16* U = (bf16*)(WSP + WS_R1);
    const float* cw = A.in[I_CONVW] + (size_t)l * 3 * 512 + lane * 8;
    float w0[8], w1[8], w2[8];
#pragma unroll
    for (int e = 0; e < 8; ++e) { w0[e] = cw[e]; w1[e] = cw[512 + e]; w2[e] = cw[1024 + e]; }
    for (int m = gw; m < MTOK; m += NGW) {
        const int t = (m < MCTX) ? (m & 255) : ((m - MCTX) & (SEQL - 1)); const int T = (m < MCTX) ? SEQC : SEQL;
        const bf16* pp = U + U_P + (size_t)m * 512 + lane * 8;
        const v4u z = (v4u){0u, 0u, 0u, 0u};
        const v4u pc = *(const v4u*)pp, pm = (t > 0) ? *(const v4u*)(pp - 512) : z, pn = (t < T - 1) ? *(const v4u*)(pp + 512) : z;
        bf16* cbp = U + U_CB + (size_t)m * 512 + lane * 8;
        const v4u cb = *(const v4u*)cbp;
        float r[8];
        const unsigned pcw[4] = {pc.x, pc.y, pc.z, pc.w}, pmw[4] = {pm.x, pm.y, pm.z, pm.w}, pnw[4] = {pn.x, pn.y, pn.z, pn.w}, cbw[4] = {cb.x, cb.y, cb.z, cb.w};
#pragma unroll
        for (int q = 0; q < 4; ++q) {
            r[2 * q] = blo(cbw[q]) * (w0[2 * q] * blo(pmw[q]) + w1[2 * q] * blo(pcw[q]) + w2[2 * q] * blo(pnw[q]));
            r[2 * q + 1] = bhi(cbw[q]) * (w0[2 * q + 1] * bhi(pmw[q]) + w1[2 * q + 1] * bhi(pcw[q]) + w2[2 * q + 1] * bhi(pnw[q]));
        }
        v4u o; o.x = pk2(r[0], r[1]); o.y = pk2(r[2], r[3]); o.z = pk2(r[4], r[5]); o.w = pk2(r[6], r[7]);
        *(v4u*)cbp = o;
    }
}
__device__ __forceinline__ float log_gamma_of(CArgs& A, int l, int dir, int h) {
    const float x = A.in[I_DECAY][(l * 2 + dir) * 4 + h]; const float e = fexp(-x);
    const float ser = e * (1.0f - e * (0.5f - e * (0.33333334f - e * (0.25f - e * 0.2f))));
    const float big = __builtin_amdgcn_logf(1.0f + e) * 0.6931471805599453f;
    return -((e < 0.0625f) ? ser : big);
}
constexpr float RET_SCALE = 0.08838834764831845f;
__device__ __forceinline__ void ret_pass1(Frame& F, int l) {
    CArgs& A = *get_args(); unsigned char* const WSP = A.ws; const int tid = F.tid;
    bf16* U = (bf16*)(WSP + WS_R1);
    LAS bf16* Ks = (LAS bf16*)F.lds; LAS bf16* Vs = Ks + 128 * 128;
    float* LB = (float*)(WSP + WS_T);
    for (int unit = F.vcu; unit < 512; unit += F.G) {
        const int chunk = unit >> 2, h = unit & 3, m0 = chunk * 128;
        __syncthreads();
        for (int i = tid; i < 2048; i += 512) { const int j = i >> 4, c8 = (i & 15) * 8;
            *(LAS v4u*)(Ks + j * 128 + c8) = *(const v4u*)(U + U_RK + (size_t)(m0 + j) * 512 + h * 128 + c8);
            *(LAS v4u*)(Vs + j * 128 + c8) = *(const v4u*)(U + U_RV + (size_t)(m0 + j) * 512 + h * 128 + c8); }
        __syncthreads();
        const float lgf = log_gamma_of(A, l, 0, h), lgb = log_gamma_of(A, l, 1, h);
        const int d = tid >> 2, e0 = (tid & 3) * 32;
        float af[32], ab[32];
#pragma unroll
        for (int e = 0; e < 32; ++e) { af[e] = 0.f; ab[e] = 0.f; }
        for (int j = 0; j < 128; ++j) {
            const float kd = bf2f(Ks[j * 128 + d]) * RET_SCALE;
            const float kf = kd * fexp(lgf * (float)(127 - j)), kb = kd * fexp(lgb * (float)j);
#pragma unroll
            for (int q = 0; q < 4; ++q) { const v4u vv = *(const LAS v4u*)(Vs + j * 128 + e0 + q * 8);
                const float v8[8] = {blo(vv.x), bhi(vv.x), blo(vv.y), bhi(vv.y), blo(vv.z), bhi(vv.z), blo(vv.w), bhi(vv.w)};
#pragma unroll
                for (int e = 0; e < 8; ++e) { af[q * 8 + e] += kf * v8[e]; ab[q * 8 + e] += kb * v8[e]; } }
        }
        float* of = LB + ((size_t)(unit * 2 + 0) * 16384) + d * 128 + e0; float* ob = LB + ((size_t)(unit * 2 + 1) * 16384) + d * 128 + e0;
#pragma unroll
        for (int q = 0; q < 8; ++q) { *(f32x4*)(of + 4 * q) = (f32x4){af[4 * q], af[4 * q + 1], af[4 * q + 2], af[4 * q + 3]}; *(f32x4*)(ob + 4 * q) = (f32x4){ab[4 * q], ab[4 * q + 1], ab[4 * q + 2], ab[4 * q + 3]}; }
    }
}
__device__ __forceinline__ void ret_scan(Frame& F, int l) {
    CArgs& A = *get_args(); unsigned char* const WSP = A.ws;
    const float* LB = (const float*)(WSP + WS_T); float* SB = (float*)(WSP + WS_GS);
    const int gt = F.bx * 512 + F.tid, NT = F.G * 512;
    for (int i = gt; i < 65536; i += NT) {
        const int e4 = i & 4095, dir = (i >> 12) & 1, h = (i >> 13) & 3, b = i >> 15;
        const float g128 = fexp(128.0f * log_gamma_of(A, l, dir, h));
        f32x4 S = *(const f32x4*)(A.in[I_STATE] + ((size_t)(((b * 2 + l) * 2 + dir) * 4 + h) * 16384) + e4 * 4);
        for (int cc = 0; cc < 32; ++cc) {
            const int c = dir == 0 ? cc : 31 - cc; const int lc = b * 32 + c, chunk = 64 + lc;
            *(f32x4*)(SB + ((size_t)((lc * 4 + h) * 2 + dir) * 16384) + e4 * 4) = S;
            const f32x4 Lc = *(const f32x4*)(LB + ((size_t)((chunk * 4 + h) * 2 + dir) * 16384) + e4 * 4);
            S = S * g128 + Lc;
        }
    }
    for (int i = gt; i < 32 * 2 * 4 * 4096; i += NT) {
        const int e4 = i & 4095, h = (i >> 12) & 3, dir = (i >> 14) & 1, b = i >> 15;
        const float g128 = fexp(128.0f * log_gamma_of(A, l, dir, h));
        const int c_first = dir == 0 ? 0 : 1, c_second = 1 - c_first;
        const f32x4 L1 = *(const f32x4*)(LB + ((size_t)(((b * 2 + c_first) * 4 + h) * 2 + dir) * 16384) + e4 * 4);
        const f32x4 L2 = *(const f32x4*)(LB + ((size_t)(((b * 2 + c_second) * 4 + h) * 2 + dir) * 16384) + e4 * 4);
        *(f32x4*)(A.out + OUT_STATE + ((size_t)(((b * 2 + l) * 2 + dir) * 4 + h) * 16384) + e4 * 4) = L1 * g128 + L2;
    }
}
__device__ __forceinline__ void ret_pass3(Frame& F, int l) {
    CArgs& A = *get_args(); unsigned char* const WSP = A.ws; const int tid = F.tid;
    bf16* U = (bf16*)(WSP + WS_R1);
    LAS bf16* Qs = (LAS bf16*)F.lds; LAS bf16* KVs = Qs + 128 * 128; LAS float* As = (LAS float*)(F.lds + 65536);
    const float* LB = (const float*)(WSP + WS_T); const float* SB = (const float*)(WSP + WS_GS);
    for (int unit = F.vcu; unit < 512; unit += F.G) {
        const int chunk = unit >> 2, h = unit & 3, m0 = chunk * 128;
        __syncthreads();
        for (int i = tid; i < 2048; i += 512) { const int j = i >> 4, c8 = (i & 15) * 8;
            *(LAS v4u*)(Qs + j * 128 + c8) = *(const v4u*)(U + U_RQ + (size_t)(m0 + j) * 512 + h * 128 + c8);
            *(LAS v4u*)(KVs + j * 128 + c8) = *(const v4u*)(U + U_RK + (size_t)(m0 + j) * 512 + h * 128 + c8); }
        __syncthreads();
        const float lgf = log_gamma_of(A, l, 0, h), lgb = log_gamma_of(A, l, 1, h);
        const int i = tid >> 2, jq = tid & 3;
        {
            float acc[32];
#pragma unroll
            for (int jj = 0; jj < 32; ++jj) acc[jj] = 0.f;
            for (int db = 0; db < 16; ++db) {
                const v4u qw = *(const LAS v4u*)(Qs + i * 128 + db * 8);
                const float q8[8] = {blo(qw.x), bhi(qw.x), blo(qw.y), bhi(qw.y), blo(qw.z), bhi(qw.z), blo(qw.w), bhi(qw.w)};
#pragma unroll
                for (int jj = 0; jj < 32; ++jj) { const v4u kw = *(const LAS v4u*)(KVs + (jq + 4 * jj) * 128 + db * 8);
                    acc[jj] += q8[0] * blo(kw.x) + q8[1] * bhi(kw.x) + q8[2] * blo(kw.y) + q8[3] * bhi(kw.y) + q8[4] * blo(kw.z) + q8[5] * bhi(kw.z) + q8[6] * blo(kw.w) + q8[7] * bhi(kw.w); }
            }
#pragma unroll
            for (int jj = 0; jj < 32; ++jj) { const int j = jq + 4 * jj;
                const float dm = (i > j) ? fexp(lgf * (float)(i - j)) : ((j > i) ? fexp(lgb * (float)(j - i)) : 2.0f);
                As[i * 128 + j] = acc[jj] * dm * RET_SCALE; }
        }
        __syncthreads();
        for (int ii = tid; ii < 2048; ii += 512) { const int j = ii >> 4, c8 = (ii & 15) * 8;
            *(LAS v4u*)(KVs + j * 128 + c8) = *(const v4u*)(U + U_RV + (size_t)(m0 + j) * 512 + h * 128 + c8); }
        __syncthreads();
        const int e0 = jq * 32;
        float o[32];
#pragma unroll
        for (int e = 0; e < 32; ++e) o[e] = 0.f;
        for (int j = 0; j < 128; ++j) { const float a = As[i * 128 + j];
#pragma unroll
            for (int q = 0; q < 4; ++q) { const v4u vv = *(const LAS v4u*)(KVs + j * 128 + e0 + q * 8);
                o[q * 8 + 0] += a * blo(vv.x); o[q * 8 + 1] += a * bhi(vv.x); o[q * 8 + 2] += a * blo(vv.y); o[q * 8 + 3] += a * bhi(vv.y);
                o[q * 8 + 4] += a * blo(vv.z); o[q * 8 + 5] += a * bhi(vv.z); o[q * 8 + 6] += a * blo(vv.w); o[q * 8 + 7] += a * bhi(vv.w); } }
        const float* Sf = nullptr; const float* Sb = nullptr;
        if (chunk < 64) { const int b = chunk >> 1, c = chunk & 1;
            if (c == 1) Sf = LB + ((size_t)((((b * 2 + 0) * 4 + h) * 2 + 0)) * 16384); else Sb = LB + ((size_t)((((b * 2 + 1) * 4 + h) * 2 + 1)) * 16384);
        } else { const int lc = chunk - 64; Sf = SB + ((size_t)((lc * 4 + h) * 2 + 0) * 16384); Sb = SB + ((size_t)((lc * 4 + h) * 2 + 1) * 16384); }
        const float dqf = fexp(lgf * (float)(i + 1)), dqb = fexp(lgb * (float)(128 - i));
        if (Sf) { for (int d = 0; d < 128; ++d) { const float qd = bf2f(Qs[i * 128 + d]) * dqf; const float* sp = Sf + d * 128 + e0;
#pragma unroll
                for (int q = 0; q < 8; ++q) { const f32x4 s = *(const f32x4*)(sp + 4 * q); o[4 * q] += qd * s.x; o[4 * q + 1] += qd * s.y; o[4 * q + 2] += qd * s.z; o[4 * q + 3] += qd * s.w; } } }
        if (Sb) { for (int d = 0; d < 128; ++d) { const float qd = bf2f(Qs[i * 128 + d]) * dqb; const float* sp = Sb + d * 128 + e0;
#pragma unroll
                for (int q = 0; q < 8; ++q) { const f32x4 s = *(const f32x4*)(sp + 4 * q); o[4 * q] += qd * s.x; o[4 * q + 1] += qd * s.y; o[4 * q + 2] += qd * s.z; o[4 * q + 3] += qd * s.w; } } }
        float ss = 0.f;
#pragma unroll
        for (int e = 0; e < 32; ++e) ss += o[e] * o[e];
        ss += __shfl_xor(ss, 1); ss += __shfl_xor(ss, 2);
        const float r = frsq(ss * (1.0f / 128.0f) + EPS);
        const float* gn = A.in[I_RETGN] + l * 512 + h * 128 + e0;
        const bf16* sg = U + U_SRG + (size_t)(m0 + i) * 512 + h * 128 + e0;
        bf16* op = U + U_RQ + (size_t)(m0 + i) * 512 + h * 128 + e0;
#pragma unroll
        for (int q = 0; q < 4; ++q) { const v4u g = *(const v4u*)(sg + q * 8);
            const float g8[8] = {blo(g.x), bhi(g.x), blo(g.y), bhi(g.y), blo(g.z), bhi(g.z), blo(g.w), bhi(g.w)};
            float y[8];
#pragma unroll
            for (int e = 0; e < 8; ++e) y[e] = o[q * 8 + e] * r * gn[q * 8 + e] * g8[e];
            v4u w; w.x = pk2(y[0], y[1]); w.y = pk2(y[2], y[3]); w.z = pk2(y[4], y[5]); w.w = pk2(y[6], y[7]);
            *(v4u*)(op + q * 8) = w; }
    }
}
__device__ __forceinline__ void attn_naive(Frame& F, int l) {
    CArgs& A = *get_args(); unsigned char* const WSP = A.ws;
    const int tid = F.tid;
    bf16* U = (bf16*)(WSP + WS_R1);
    LAS bf16* KT = (LAS bf16*)F.lds;
    LAS bf16* VT = KT + 64 * 64;
    const int tq = tid >> 1, dh = (tid & 1) * 32;
    for (int it = F.vcu; it < 512; it += F.G) {
        int m0, hh, S; const bf16* Kb; const bf16* Vb;
        if (it >= 256) { const int i = it - 256, b = i >> 3; hh = i & 7; m0 = b * 256; S = 256;
            Kb = (const bf16*)(WSP + WS_KC) + (size_t)(b * 2 + (hh >> 2)) * 256 * 64; Vb = (const bf16*)(WSP + WS_VC) + (size_t)(b * 2 + (hh >> 2)) * 256 * 64;
        } else { const int b = it >> 7, qb = it & 15; hh = (it >> 4) & 7; m0 = MCTX + b * SEQL + qb * 256; S = SKL;
            Kb = (const bf16*)(WSP + WS_KL) + (size_t)((l * 2 + b) * 2 + (hh >> 2)) * SKL * 64; Vb = (const bf16*)(WSP + WS_VL) + (size_t)((l * 2 + b) * 2 + (hh >> 2)) * SKL * 64; }
        bf16* qp = U + U_AQ + (size_t)(m0 + tq) * 512 + hh * 64 + dh;
        float q[32], o[32];
#pragma unroll
        for (int c = 0; c < 4; ++c) { const v4u w = *(const v4u*)(qp + c * 8);
            q[c * 8] = blo(w.x); q[c * 8 + 1] = bhi(w.x); q[c * 8 + 2] = blo(w.y); q[c * 8 + 3] = bhi(w.y); q[c * 8 + 4] = blo(w.z); q[c * 8 + 5] = bhi(w.z); q[c * 8 + 6] = blo(w.w); q[c * 8 + 7] = bhi(w.w); }
#pragma unroll
        for (int d = 0; d < 32; ++d) o[d] = 0.f;
        float mrun = -INFINITY, lrun = 0.f;
        const int ntile = S >> 6;
        for (int t = 0; t < ntile; ++t) {
            __syncthreads();
            { const int r = tid >> 3, c8 = (tid & 7) * 8; const size_t g = (size_t)(t * 64 + r) * 64 + c8;
              *(LAS v4u*)(KT + r * 64 + c8) = *(const v4u*)(Kb + g); *(LAS v4u*)(VT + r * 64 + c8) = *(const v4u*)(Vb + g); }
            __syncthreads();
#pragma unroll 1
            for (int jb = 0; jb < 64; jb += 4) {
                float s[4]; float tmax = -INFINITY;
#pragma unroll
                for (int j = 0; j < 4; ++j) { float a = 0.f;
#pragma unroll
                    for (int c = 0; c < 4; ++c) { const v4u w = *(const LAS v4u*)(KT + (jb + j) * 64 + dh + c * 8);
                        a += q[c * 8] * blo(w.x) + q[c * 8 + 1] * bhi(w.x) + q[c * 8 + 2] * blo(w.y) + q[c * 8 + 3] * bhi(w.y) + q[c * 8 + 4] * blo(w.z) + q[c * 8 + 5] * bhi(w.z) + q[c * 8 + 6] * blo(w.w) + q[c * 8 + 7] * bhi(w.w); }
                    a += __shfl_xor(a, 1);
                    s[j] = a; tmax = fmaxf(tmax, a); }
                const float mnew = fmaxf(mrun, tmax), alpha = fexp2(mrun - mnew);
                lrun *= alpha;
#pragma unroll
                for (int d = 0; d < 32; ++d) o[d] *= alpha;
#pragma unroll
                for (int j = 0; j < 4; ++j) { const float p = fexp2(s[j] - mnew); lrun += p;
#pragma unroll
                    for (int c = 0; c < 4; ++c) { const v4u w = *(const LAS v4u*)(VT + (jb + j) * 64 + dh + c * 8);
                        o[c * 8] += p * blo(w.x); o[c * 8 + 1] += p * bhi(w.x); o[c * 8 + 2] += p * blo(w.y); o[c * 8 + 3] += p * bhi(w.y); o[c * 8 + 4] += p * blo(w.z); o[c * 8 + 5] += p * bhi(w.z); o[c * 8 + 6] += p * blo(w.w); o[c * 8 + 7] += p * bhi(w.w); } }
                mrun = mnew;
            }
        }
        const float inv = 1.0f / lrun;
#pragma unroll
        for (int c = 0; c < 4; ++c) { float y[8];
#pragma unroll
            for (int e = 0; e < 8; ++e) y[e] = o[c * 8 + e] * inv;
            v4u w; w.x = pk2(y[0], y[1]); w.y = pk2(y[2], y[3]); w.z = pk2(y[4], y[5]); w.w = pk2(y[6], y[7]);
            *(v4u*)(qp + c * 8) = w; }
    }
    __syncthreads();
}


#ifndef USE_MFMA_ATTN
#define USE_MFMA_ATTN 1
#endif
__device__ __forceinline__ void attn_mfma(Frame& F, int l) {
    CArgs& A = *get_args(); unsigned char* const WSP = A.ws;
    const attn_body::bf16* U = (const attn_body::bf16*)(WSP + WS_R1);
    __syncthreads();
    for (int it = F.vcu; it < 512; it += F.G) {
        int m0, hh, NT; const attn_body::bf16* Kb; const attn_body::bf16* Vb;
        if (it >= 256) { const int i = it - 256, b = i >> 3; hh = i & 7; m0 = b * 256; NT = 4;
            Kb = (const attn_body::bf16*)(WSP + WS_KC) + (size_t)(b * 2 + (hh >> 2)) * 256 * 64; Vb = (const attn_body::bf16*)(WSP + WS_VC) + (size_t)(b * 2 + (hh >> 2)) * 256 * 64;
        } else { const int b = it >> 7, qb = it & 15; hh = (it >> 4) & 7; m0 = MCTX + b * SEQL + qb * 256; NT = SKL / 64;
            Kb = (const attn_body::bf16*)(WSP + WS_KL) + (size_t)((l * 2 + b) * 2 + (hh >> 2)) * SKL * 64; Vb = (const attn_body::bf16*)(WSP + WS_VL) + (size_t)((l * 2 + b) * 2 + (hh >> 2)) * SKL * 64; }
        attn_body::bf16* qo = (attn_body::bf16*)(U + U_AQ + (size_t)m0 * 512 + hh * 64);
        attn_body::attn_unit<8>(qo, Kb, Vb, qo, NT, (char*)F.lds, F.tid);
    }
    asm volatile("s_waitcnt vmcnt(0) lgkmcnt(0)" ::: "memory"); __syncthreads();
}

#ifndef DBG
#define DBG 0
#endif
#if DBG
constexpr int CW_DBG = 2048;
__device__ __forceinline__ void dbg_report(unsigned* ctl, int check, float got, float ref, int lane) {
    const float err = fabsf(got - ref), tol = 0.05f * fabsf(ref) + 0.05f;
    const float rel = err / (fabsf(ref) + 0.5f);
    if (!(err <= tol)) atomicOr(ctl + CW_DBG, 1u << check);
    atomicMax(ctl + CW_DBG + 1 + check, __float_as_uint(rel == rel ? rel : 1e30f));
    atomicAdd((float*)(ctl + CW_DBG + 64 + 2 * check), err * err); atomicAdd((float*)(ctl + CW_DBG + 65 + 2 * check), ref * ref);
}
__device__ __forceinline__ float dbg_dot(const bf16* arow, const float* W, int K, int srcN, int col, int lane) {
    float a = 0.f; for (int k = lane; k < K; k += 64) a += bf2f(arow[k]) * W[(size_t)k * srcN + col]; return wave_sum(a);
}
__device__ __forceinline__ float dbg_sig(float x) { return 1.0f / (1.0f + __expf(-x)); }
__device__ __forceinline__ float dbg_qk_dim(CArgs& A, unsigned char* ws, int l, int m, int slot, int lane) {
    const bf16* xn = (const bf16*)(ws + WS_XN) + (size_t)m * DM;
    const float* W = A.in[I_WIN] + (size_t)l * DM * NIN_SRC;
    const int col0 = slot < 8 ? 2048 + slot * 64 : 2560 + (slot - 8) * 64;
    float mine = 0.f;
    for (int d = 0; d < 64; ++d) { const float v = dbg_dot(xn, W, DM, NIN_SRC, col0 + d, lane); if (d == lane) mine = v; }
    mine = bf2f((unsigned short)f2bf(mine));
    const float ss = wave_sum(mine * mine);
    const float g = slot < 8 ? A.in[I_QG][l * 64 + lane] : A.in[I_KG][l * 64 + lane];
    float y = mine * (1.0f / sqrtf(ss / 64.0f + EPS)) * g;
    if (m >= MCTX) {
        const int t = (m - MCTX) % SEQL, row = t / 64, colp = t % 64, i = lane & 31;
        const float pos = (i < 16) ? (float)row : (float)colp; const int fi = i & 15;
        const float inv = __powf(10000.0f, -(float)fi / 16.0f); const float ang = pos * inv;
        const float c = __cosf(ang), sn = __sinf(ang);
        const float other = __shfl_xor(y, 32);
        y = (lane < 32) ? (y * c - other * sn) : (other * sn + y * c);
    }
    return y;
}
__device__ __forceinline__ void dbg_checks(Frame& F, int check) {
    CArgs& A = *get_args(); unsigned char* const ws = A.ws; unsigned* ctl = (unsigned*)(ws + WS_CTL);
    const int gw = F.bx * NWAVES + F.wave, lane = F.lane;
    const float* mod = (const float*)(ws + WS_MOD);
    const bf16* XN = (const bf16*)(ws + WS_XN); const bf16* U = (const bf16*)(ws + WS_R1);
    if (check == 40) {
        const bf16* WG = (const bf16*)(ws + WS_WG); const bf16* GSb = (const bf16*)(ws + WS_GS);
        for (size_t o = (size_t)F.bx * 512 + F.tid; o < (size_t)MTOK * DM; o += (size_t)F.G * 512) {
            const int mm = (int)(o >> 10), n = (int)(o & 1023); const v4u* xr = (const v4u*)(XN + (size_t)mm * DM); const v4u* wr_ = (const v4u*)(WG + (size_t)n * DM);
            float acc = 0.f;
            for (int k8 = 0; k8 < 128; ++k8) { const v4u a = xr[k8], b = wr_[k8];
                acc += blo(a.x) * blo(b.x) + bhi(a.x) * bhi(b.x) + blo(a.y) * blo(b.y) + bhi(a.y) * bhi(b.y) + blo(a.z) * blo(b.z) + bhi(a.z) * bhi(b.z) + blo(a.w) * blo(b.w) + bhi(a.w) * bhi(b.w); }
            const float ref = dbg_sig(acc), got = bf2f(GSb[o]);
            if ((mm & 255) >= 128 && (mm & 63) >= 48 && (n & 128)) { const float raw = ((const float*)(ws + WS_T))[o]; if (!(fabsf(raw - acc) <= 0.02f + 0.01f * fabsf(acc))) atomicAdd(ctl + CW_DBG + 210, 1u); else atomicAdd(ctl + CW_DBG + 211, 1u); }
            if (!(fabsf(got - ref) <= 0.02f)) { atomicAdd(ctl + CW_DBG + 200, 1u); atomicAdd(ctl + CW_DBG + 256 + (mm >> 8), 1u); atomicAdd(ctl + CW_DBG + 384 + (mm & 255), 1u); atomicAdd(ctl + CW_DBG + 201 + ((n >> 7) & 1), 1u); }
        }
        return; }
    if (check == 41) {
        const bf16* WI = (const bf16*)(ws + WS_WINM) + (size_t)1536 * DM; const bf16* SR = U + U_SRG;
        for (size_t o = (size_t)F.bx * 512 + F.tid; o < (size_t)MTOK * 512; o += (size_t)F.G * 512) {
            const int mm = (int)(o >> 9), n = (int)(o & 511); const v4u* xr = (const v4u*)(XN + (size_t)mm * DM); const v4u* wr_ = (const v4u*)(WI + (size_t)n * DM);
            float acc = 0.f;
            for (int k8 = 0; k8 < 128; ++k8) { const v4u a = xr[k8], b = wr_[k8];
                acc += blo(a.x) * blo(b.x) + bhi(a.x) * bhi(b.x) + blo(a.y) * blo(b.y) + bhi(a.y) * bhi(b.y) + blo(a.z) * blo(b.z) + bhi(a.z) * bhi(b.z) + blo(a.w) * blo(b.w) + bhi(a.w) * bhi(b.w); }
            const float ref = acc * dbg_sig(acc), got = bf2f(SR[o]);
            if (!(fabsf(got - ref) <= 0.02f + 0.02f * fabsf(ref))) { atomicAdd(ctl + CW_DBG + 200, 1u); atomicAdd(ctl + CW_DBG + 256 + (mm >> 8), 1u); atomicAdd(ctl + CW_DBG + 384 + (mm & 255), 1u); atomicAdd(ctl + CW_DBG + 201 + ((n >> 7) & 1), 1u); }
        }
        return; }
    if (check == 30 || check == 31) {
        const unsigned* X = (const unsigned*)XN; unsigned acc = 0, accf = 0;
        for (size_t i = (size_t)F.bx * 512 + F.tid; i < (size_t)MTOK * DM / 2; i += (size_t)F.G * 512) { const unsigned w = X[i]; acc += w * 2654435761u + (unsigned)i; const size_t row = i / 512; if (row >= 10168 && row < 10176) accf += w * 2654435761u + (unsigned)i; }
        atomicAdd(ctl + CW_DBG + 100 + (check - 30), acc); atomicAdd(ctl + CW_DBG + 102 + (check - 30), accf);
        return; }
    if (check >= 20 && check < 26) {
        const int step = check - 20, b = step >> 1; const float* W = A.in[I_WIN];
        for (int rep = 0; rep < 4; ++rep) { const int m = 10168 + (gw & 7); const int n = ((gw >> 3) + 256 * rep) % DM;
            float tsum = 0.f, gl = 0.f;
            for (int bb = 0; bb <= b; ++bb) { const float g = dbg_sig(dbg_dot(XN + (size_t)m * DM, W, DM, NIN_SRC, NINM + 1024 * bb + n, lane)); gl = g;
                if (bb < b || (step & 1)) { const bf16* Ab = U + (bb == 0 ? U_RQ : (bb == 1 ? U_AQ : U_CB)) + (size_t)m * 512;
                    const float* Wo = (bb == 0 ? A.in[I_WRO] : (bb == 1 ? A.in[I_WAO] : A.in[I_WCO])); tsum += g * dbg_dot(Ab, Wo, 512, DM, n, lane); } }
            if (step == 0) { float mx = 0.f; for (int k = lane; k < DM; k += 64) mx = fmaxf(mx, fabsf(bf2f(XN[(size_t)m * DM + k])));
                for (int o = 1; o < 64; o <<= 1) mx = fmaxf(mx, __shfl_xor(mx, o));
                float a2 = 0.f; for (int k = lane; k < DM; k += 64) a2 += bf2f(XN[(size_t)m * DM + k]) * bf2f((unsigned short)f2bf(W[(size_t)k * NIN_SRC + NINM + n])); a2 = dbg_sig(wave_sum(a2));
                float rn = 0.f; for (int k = lane; k < DM; k += 64) { const float x = bf2f(XN[(size_t)m * DM + k]); rn += x * x; } rn = sqrtf(wave_sum(rn));
                if (lane == 0) { atomicMax(ctl + CW_DBG + 61, __float_as_uint(rn)); const float gsv = bf2f(((const bf16*)(ws + WS_GS))[(size_t)m * DM + n]); if (!(fabsf(gsv - gl) <= 0.05f * gl + 0.05f)) atomicAdd(ctl + CW_DBG + 60, 1u);
                    if (!(fabsf(gsv - a2) <= 0.05f * a2 + 0.05f)) { atomicAdd(ctl + CW_DBG + 62, 1u); atomicOr(ctl + CW_DBG + 110, 1u << (n >> 7)); atomicOr(ctl + CW_DBG + 111, 1u << ((n >> 3) & 15)); atomicOr(ctl + CW_DBG + 112, 1u << (n & 7)); } } }
            if (lane == 0) { if ((step & 1) == 0) dbg_report(ctl, step, bf2f(((const bf16*)(ws + WS_GS))[(size_t)m * DM + n]), gl, lane);
                else if (b < 2) dbg_report(ctl, step, ((const float*)(ws + WS_T))[(size_t)m * DM + n], tsum, lane);
                else dbg_report(ctl, step, bf2f(U[U_MG + (size_t)m * DM + n]), tsum, lane); } }
        return; }
    const int l = check >= 16 ? 1 : 0; check &= 15; const int rb01 = (l == 1) ? 3 : check;
  for (int rep = 0; rep < 4; ++rep) {
    const int m = 10168 + (gw & 7); const int ci = cond_of_row(m); const int sidx = (gw >> 3) + 256 * rep;
    if (check == 0) {
        if (rep > 0) continue;
        const int h = sidx & 3;
        const bf16* xn = XN + (size_t)m * DM; const float* W = A.in[I_WIN] + (size_t)l * DM * NIN_SRC;
        float q0 = 0.f, q1 = 0.f;
        for (int d = 0; d < 128; ++d) { float a = 0.f; for (int k = lane; k < DM; k += 64) a += bf2f(xn[k]) * bf2f((unsigned short)f2bf(W[(size_t)k * NIN_SRC + h * 128 + d])); const float v = bf2f((unsigned short)f2bf(wave_sum(a))); if (d == lane) q0 = v; if (d == lane + 64) q1 = v; }
        int mb, T, n; const float* S0f = nullptr; const float* S0b = nullptr;
        if (m < MCTX) { mb = m & ~255; T = 256; n = m & 255; } else { const int bb = (m - MCTX) >> 12; mb = MCTX + bb * SEQL; T = SEQL; n = (m - MCTX) & (SEQL - 1);
            S0f = A.in[I_STATE] + ((size_t)(((bb * 2 + l) * 2 + 0) * 4 + h) * 16384); S0b = A.in[I_STATE] + ((size_t)(((bb * 2 + l) * 2 + 1) * 4 + h) * 16384); }
        const float xf = A.in[I_DECAY][(l * 2 + 0) * 4 + h], xb = A.in[I_DECAY][(l * 2 + 1) * 4 + h];
        const float lgf = -logf(1.0f + __expf(-xf)), lgb = -logf(1.0f + __expf(-xb));
        float o0 = 0.f, o1 = 0.f;
        for (int j = 0; j < T; ++j) {
            const bf16* kr = U + U_RK + (size_t)(mb + j) * 512 + h * 128; const bf16* vr = U + U_RV + (size_t)(mb + j) * 512 + h * 128;
            const float sdot = wave_sum(q0 * bf2f(kr[lane]) + q1 * bf2f(kr[lane + 64])) * RET_SCALE;
            const float w = (j < n) ? __expf(lgf * (float)(n - j)) : ((j > n) ? __expf(lgb * (float)(j - n)) : 2.0f);
            o0 += w * sdot * bf2f(vr[lane]); o1 += w * sdot * bf2f(vr[lane + 64]);
        }
        if (S0f) { const float df = __expf(lgf * (float)(n + 1)), db = __expf(lgb * (float)(T - n));
            for (int d = 0; d < 128; ++d) { const float qd = __shfl(d < 64 ? q0 : q1, d & 63);
                o0 += qd * (df * S0f[d * 128 + lane] + db * S0b[d * 128 + lane]); o1 += qd * (df * S0f[d * 128 + lane + 64] + db * S0b[d * 128 + lane + 64]); } }
        const float r = 1.0f / sqrtf(wave_sum(o0 * o0 + o1 * o1) / 128.0f + EPS);
        const float* gn = A.in[I_RETGN] + l * 512 + h * 128;
        const float r0 = o0 * r * gn[lane] * bf2f(U[U_SRG + (size_t)m * 512 + h * 128 + lane]), r1 = o1 * r * gn[lane + 64] * bf2f(U[U_SRG + (size_t)m * 512 + h * 128 + lane + 64]);
        { const int slot = rb01; dbg_report(ctl, slot, bf2f(U[U_RQ + (size_t)m * 512 + h * 128 + lane]), r0, lane); dbg_report(ctl, slot, bf2f(U[U_RQ + (size_t)m * 512 + h * 128 + lane + 64]), r1, lane); }
    } else if (check == 1) {
        if (rep > 0) continue;
        const int h = sidx & 7, kv = h >> 2; const float q = dbg_qk_dim(A, ws, l, m, h, lane) * 0.125f;
        const bf16* Kb; const bf16* Vb; int S;
        if (m < MCTX) { const int bb = m >> 8; S = 256; Kb = (const bf16*)(ws + WS_KC) + (size_t)(bb * 2 + kv) * 256 * 64; Vb = (const bf16*)(ws + WS_VC) + (size_t)(bb * 2 + kv) * 256 * 64; }
        else { const int bb = (m - MCTX) >> 12; S = SKL; Kb = (const bf16*)(ws + WS_KL) + (size_t)((l * 2 + bb) * 2 + kv) * SKL * 64; Vb = (const bf16*)(ws + WS_VL) + (size_t)((l * 2 + bb) * 2 + kv) * SKL * 64; }
        float mx = -1e30f; for (int j = 0; j < S; ++j) mx = fmaxf(mx, wave_sum(q * bf2f(Kb[(size_t)j * 64 + lane])));
        float den = 0.f, o = 0.f; for (int j = 0; j < S; ++j) { const float p = __expf(wave_sum(q * bf2f(Kb[(size_t)j * 64 + lane])) - mx); den += p; o += p * bf2f(Vb[(size_t)j * 64 + lane]); }
        dbg_report(ctl, rb01, bf2f(U[U_AQ + (size_t)m * 512 + h * 64 + lane]), o / den, lane);
    } else if (check == 2) {
        const int n = sidx % DM; const float* W = A.in[I_WIN] + (size_t)l * DM * NIN_SRC; float ref = 0.f; float term[3];
        for (int b = 0; b < 3; ++b) { const float g = dbg_dot(XN + (size_t)m * DM, W, DM, NIN_SRC, NINM + 1024 * b + n, lane);
            const bf16* Ab = U + (b == 0 ? U_RQ : (b == 1 ? U_AQ : U_CB)) + (size_t)m * 512;
            const float* Wo = (b == 0 ? A.in[I_WRO] : (b == 1 ? A.in[I_WAO] : A.in[I_WCO])) + (size_t)l * 512 * DM;
            term[b] = dbg_sig(g) * dbg_dot(Ab, Wo, 512, DM, n, lane); ref += term[b]; }
        if (lane == 0) { dbg_report(ctl, 2, bf2f(U[U_MG + (size_t)m * DM + n]), ref, lane);
            const float got = bf2f(U[U_MG + (size_t)m * DM + n]); if (!(fabsf(got - ref) <= 0.05f * fabsf(ref) + 0.05f)) { atomicAdd(ctl + CW_DBG + 60, 1u);
                for (int b = 0; b < 3; ++b) { const float alt = ref - term[b]; if (fabsf(got - alt) <= 0.05f * fabsf(alt) + 0.05f) atomicAdd(ctl + CW_DBG + 50 + b, 1u); }
                const float gs = bf2f(((const bf16*)(ws + WS_GS))[(size_t)m * DM + n]); const float tt = ((const float*)(ws + WS_T))[(size_t)m * DM + n];
                const float t01 = term[0] + term[1]; if (!(fabsf(tt - t01) <= 0.05f * fabsf(t01) + 0.05f)) atomicAdd(ctl + CW_DBG + 53, 1u);
                const float g2 = dbg_sig(dbg_dot(XN + (size_t)m * DM, W, DM, NIN_SRC, NINM + 2048 + n, lane)); (void)g2; } }
    } else if (check == 3) {
        if (rep > 0) continue;
        float* T = (float*)(ws + WS_T); for (size_t i = (size_t)F.bx * 512 + F.tid; i < (size_t)MTOK * DM; i += (size_t)F.G * 512) T[i] = A.out[i];
    } else if (check == 4) {
        const int n = sidx % DM; const float* T = (const float*)(ws + WS_T);
        const float d = dbg_dot(U + U_MG + (size_t)m * DM, A.in[I_WO] + (size_t)l * DM * DM, DM, DM, n, lane);
        const float ref = T[(size_t)m * DM + n] + mod[(size_t)(ci * 2 + l) * 9216 + 5 * 1024 + n] * d;
        if (lane == 0) dbg_report(ctl, 4, A.out[(size_t)m * DM + n], ref, lane);
    } else if (check == 5 || check == 9) {
        const int j = check == 5 ? 2 : 0; const float* x = A.out + (size_t)m * DM;
        float s2 = 0.f; for (int k = lane; k < DM; k += 64) s2 += x[k] * x[k];
        s2 = wave_sum(s2); const float rstd = 1.0f / sqrtf(s2 / DM + EPS);
        const int k = lane * 16 + 3; const float* mm = mod + (size_t)(ci * 2 + l) * 9216 + 3 * j * 1024;
        const float ref = x[k] * rstd * A.in[I_NORMW][(l * 3 + j) * DM + k] * (1.0f + mm[1024 + k]) + mm[k];
        dbg_report(ctl, check, bf2f(XN[(size_t)m * DM + k]), ref, lane);
    } else if (check == 6 || check == 10) {
        const int f = check == 6 ? 1 : 0; const int j = (gw * 131 + 5) % FFN; const float* W = A.in[I_WFFIN] + (size_t)(l * 2 + f) * DM * NFF1;
        const float g = dbg_dot(XN + (size_t)m * DM, W, DM, NFF1, j, lane), u = dbg_dot(XN + (size_t)m * DM, W, DM, NFF1, FFN + j, lane);
        if (lane == 0) dbg_report(ctl, check, bf2f(U[(size_t)m * FFN + j]), g * dbg_sig(g) * u, lane);
    } else if (check == 7) {
        const int n = (gw * 61 + 3) % DM; const float* T = (const float*)(ws + WS_T);
        const float d = dbg_dot(U + (size_t)m * FFN, A.in[I_WFFOUT] + (size_t)(l * 2 + 1) * FFN * DM, FFN, DM, n, lane);
        const float ref = T[(size_t)m * DM + n] + 0.5f * mod[(size_t)(ci * 2 + l) * 9216 + 8 * 1024 + n] * d;
        if (lane == 0) dbg_report(ctl, 7, A.out[(size_t)m * DM + n], ref, lane);
    } else if (check == 11) {
        float mx = 0.f; for (size_t i = (size_t)F.bx * 512 + F.tid; i < (size_t)MTOK * DM; i += (size_t)F.G * 512) { const float v = fabsf(A.out[i]); mx = fmaxf(mx, (v == v) ? v : 1e30f); }
        mx = fmaxf(mx, __shfl_xor(mx, 1)); mx = fmaxf(mx, __shfl_xor(mx, 2)); mx = fmaxf(mx, __shfl_xor(mx, 4)); mx = fmaxf(mx, __shfl_xor(mx, 8)); mx = fmaxf(mx, __shfl_xor(mx, 16)); mx = fmaxf(mx, __shfl_xor(mx, 32));
        if (lane == 0) atomicMax(ctl + CW_DBG + 40, __float_as_uint(mx));
    } else if (check == 13) {
        for (int p = 0; p < 3; ++p) { const bf16* P = U + (p == 0 ? U_RQ : (p == 1 ? U_AQ : U_CB)); float mx = 0.f;
            for (size_t i = (size_t)F.bx * 512 + F.tid; i < PLANE; i += (size_t)F.G * 512) { const float v = fabsf(bf2f(P[i])); mx = fmaxf(mx, (v == v) ? v : 1e30f); }
            mx = fmaxf(mx, __shfl_xor(mx, 1)); mx = fmaxf(mx, __shfl_xor(mx, 2)); mx = fmaxf(mx, __shfl_xor(mx, 4)); mx = fmaxf(mx, __shfl_xor(mx, 8)); mx = fmaxf(mx, __shfl_xor(mx, 16)); mx = fmaxf(mx, __shfl_xor(mx, 32));
            if (lane == 0) atomicMax(ctl + CW_DBG + 44 + p, __float_as_uint(mx)); }
    } else if (check == 14) {
        const float mxv = __uint_as_float(ctl[CW_DBG + 40]);
        for (size_t i = (size_t)F.bx * 512 + F.tid; i < (size_t)MTOK * DM; i += (size_t)F.G * 512) { const float v = fabsf(A.out[i]); if (v >= 0.999f * mxv) atomicMax(ctl + CW_DBG + 47, 0x7fffffffu - (unsigned)i); }
    } else if (check == 12) {
        if (F.bx == 0 && F.tid == 0) { const float mx = __uint_as_float(ctl[CW_DBG + 40]); if (mx > 30.f && ctl[CW_DBG + 41] == 0u) { ctl[CW_DBG + 41] = 1u + ctl[CW_DBG + 42]; ctl[CW_DBG + 43] = __float_as_uint(mx); } ctl[CW_DBG + 42] += 1u; }
    } else if (check == 8) {
        int c = (sidx * 4 + (gw & 3)) % NINM; if (c >= 3840) c -= 512;
        const float* W = A.in[I_WIN] + (size_t)l * DM * NIN_SRC;
        float ref = dbg_dot(XN + (size_t)m * DM, W, DM, NIN_SRC, c, lane), got;
        if (c < 512) got = bf2f(U[U_RQ + (size_t)m * 512 + c]);
        else if (c < 1024) got = bf2f(U[U_RK + (size_t)m * 512 + c - 512]);
        else if (c < 1536) got = bf2f(U[U_RV + (size_t)m * 512 + c - 1024]);
        else if (c < 2048) { got = bf2f(U[U_SRG + (size_t)m * 512 + c - 1536]); ref = ref * dbg_sig(ref); }
        else if (c < 2560) got = bf2f(U[U_AQ + (size_t)m * 512 + c - 2048]);
        else if (c < 2816) got = bf2f(U[U_AKV + (size_t)m * 256 + c - 2560]);
        else if (c < 3328) got = bf2f(U[U_CB + (size_t)m * 512 + c - 2816]);
        else { ref *= dbg_dot(XN + (size_t)m * DM, W, DM, NIN_SRC, c + 512, lane); got = bf2f(U[U_P + (size_t)m * 512 + c - 3328]); }
        if (lane == 0) dbg_report(ctl, 8, got, ref, lane);
    }
  }
}
__device__ __forceinline__ void dbg_final(Frame& F) {
    CArgs& A = *get_args(); unsigned* ctl = (unsigned*)(A.ws + WS_CTL);
    if (F.bx == 0 && F.tid == 0) {
        const unsigned mask = ctl[CW_DBG];
#if DBG == 2
        const unsigned same_all = (ctl[CW_DBG + 100] == ctl[CW_DBG + 101]) ? 1u : 0u, same_foc = (ctl[CW_DBG + 102] == ctl[CW_DBG + 103]) ? 1u : 0u;
        (void)same_all; (void)same_foc;
        const unsigned tot = ctl[CW_DBG + 60]; int lb = 0; { unsigned t = 1; while (lb < 14 && tot >= t) { ++lb; t <<= 1; } }
        const float mxx = __uint_as_float(ctl[CW_DBG + 61]); int bx2 = 0; { float t = 2.f; while (bx2 < 20 && mxx >= t) { ++bx2; t *= 2.f; } }
        const unsigned tot2 = ctl[CW_DBG + 62]; int lb2 = 0; { unsigned t = 1; while (lb2 < 9 && tot2 >= t) { ++lb2; t <<= 1; } }
        { const unsigned tot = ctl[CW_DBG + 200]; int lb = 0; { unsigned t = 1; while (lb < 30 && tot >= t) { ++lb; t <<= 1; } }
          int ntile = 0; for (int q = 0; q < 64; ++q) ntile += ctl[CW_DBG + 256 + q] ? 1 : 0; int nrow = 0; for (int q = 0; q < 256; ++q) nrow += ctl[CW_DBG + 384 + q] ? 1 : 0;
          int lr = 0; { int t = 1; while (lr < 9 && nrow >= t) { ++lr; t <<= 1; } }
#if DBG_WHICH == 0
          int minr = 255, maxr = 0; for (int q = 0; q < 256; ++q) if (ctl[CW_DBG + 384 + q] > 8u) { if (q < minr) minr = q; if (q > maxr) maxr = q; }
          { const unsigned bad = ctl[CW_DBG + 210], good = ctl[CW_DBG + 211]; int l1 = 0, l2 = 0; { unsigned t = 1; while (l1 < 30 && bad >= t) { ++l1; t <<= 1; } } { unsigned t = 1; while (l2 < 30 && good >= t) { ++l2; t <<= 1; } }
            float v = (float)(10 + l1) * 1e4f; for (int i = 0; i < l2; ++i) v *= 10.0f; A.out[0] = v; return; }
          (void)ntile; (void)lb; (void)minr; (void)maxr; int c4[4]; for (int g = 0; g < 4; ++g) { c4[g] = 0; for (int q = 0; q < 4; ++q) c4[g] += (ctl[CW_DBG + 384 + 176 + 4 * g + q] > 8u) ? 1 : 0; }
          int nall = 0; for (int q = 0; q < 256; ++q) nall += (ctl[CW_DBG + 384 + q] > 8u) ? 1 : 0;
          float v = (float)(10 + c4[0] * 5 + c4[1]) * 1e4f; for (int i = 0; i < c4[2] * 5 + c4[3]; ++i) v *= 10.0f; if (nall != 24) v = -v; A.out[0] = v; return;
#else
          const unsigned b0 = ctl[CW_DBG + 201], b1c = ctl[CW_DBG + 202]; int l0 = 0; { unsigned t = 1; while (l0 < 30 && b0 >= t) { ++l0; t <<= 1; } } (void)b1c;
          float v = (float)(10 + lr * 9) * 1e4f; for (int i = 0; i < l0; ++i) v *= 10.0f; A.out[0] = v; return;
#endif
        }
        const unsigned g128 = ctl[CW_DBG + 110] & 255u, g8 = ctl[CW_DBG + 111] & 0xffffu, g1 = ctl[CW_DBG + 112] & 255u;
#if DBG_WHICH == 0
        float v = (float)(10u + (g128 & 63u)) * 1e4f; for (unsigned i = 0; i < (g128 >> 6) + 4u * (g1 == 255u ? 1u : 0u); ++i) v *= 10.0f; A.out[0] = v;
#else
        float v = (float)(10u + (g8 & 63u)) * 1e4f; for (unsigned i = 0; i < (g8 >> 6); ++i) v *= 10.0f; A.out[0] = v;
#endif
#else
        float v = (float)(10u + (mask & 63u)) * 1e4f; for (unsigned i = 0; i < (mask >> 6); ++i) v *= 10.0f;
        A.out[0] = v;
#endif
    }
}
#endif

enum { K_PRO = 0, K_NORM, K_FFN_UP, K_FFN_DOWN, K_WIN, K_MIX1, K_SCAN, K_MIX2, K_MERGE, K_WO, K_XLAYER };
constexpr int N_PHASES = 27;
__device__ __forceinline__ void decode_phase(int ph, int& kind, int& l, int& sub) {
    if (ph >= 3000) { kind = 98; l = 0; sub = ph - 3000; return; }
    if (ph >= 1000) { kind = 99; l = 0; sub = ph - 1000; return; }
    if (ph == 0) { kind = K_PRO; l = 0; sub = 0; return; }
    if (ph == 1) { kind = K_NORM; l = 0; sub = 0; return; }
    const int q = ph - 2; l = q / 13; const int r = q % 13; sub = 0;
    switch (r) {
        case 0: kind = K_FFN_UP; sub = 0; break;
        case 1: kind = K_FFN_DOWN; sub = 0; break;
        case 2: kind = K_NORM; sub = 1; break;
        case 3: kind = K_WIN; break;
        case 4: kind = K_MIX1; break;
        case 5: kind = K_SCAN; break;
        case 6: kind = K_MIX2; break;
        case 7: kind = K_MERGE; break;
        case 8: kind = K_WO; break;
        case 9: kind = K_NORM; sub = 2; break;
        case 10: kind = K_FFN_UP; sub = 1; break;
        case 11: kind = K_FFN_DOWN; sub = 1; break;
        default: kind = K_XLAYER; break;
    }
}

__device__ __forceinline__ void ph_ffn_up(Frame& F, int f) {
    CArgs& A = *get_args(); unsigned char* const ws = A.ws;
    pg8::Gemm g{(const pg8::bf16_t*)(ws + WS_XN), (const pg8::bf16_t*)(ws + WS_WFF1) + (size_t)f * NFF1 * DM, MTOK, NFF1, DM};
    pg8::StaticOrder S; S.init(MTOK, NFF1, F.G, F.bx);
    pg8::EpiPair<1> E{(pg8::bf16_t*)(ws + WS_R1), FFN, 0};
    if (EN_UP) pg8::gemm_phase(F.lds, g, S, E, F.tid);
}
__device__ __forceinline__ void ph_resid(Frame& F, int l, int f, bool wo) {
    CArgs& A = *get_args(); unsigned char* const ws = A.ws;
    const pg8::bf16_t* R1 = (const pg8::bf16_t*)(ws + WS_R1);
    pg8::Gemm g{wo ? R1 + U_MG : R1, wo ? (const pg8::bf16_t*)(ws + WS_WO) : (const pg8::bf16_t*)(ws + WS_WFF2) + (size_t)f * DM * FFN, MTOK, DM, wo ? DM : FFN};
    pg8::StaticOrder S; S.init(MTOK, DM, F.G, F.bx);
    const bool first = (!wo && l == 0 && f == 0);
    const int gj = wo ? 5 : (f == 0 ? 2 : 8);
    float* outp = A.out;
    const float* mod = (const float*)(ws + WS_MOD);
    pg8::EpiResid E{first ? A.in[I_XP] : outp, first ? A.in[I_XS] : outp + (size_t)MCTX * DM, outp, mod + (size_t)l * 9216 + gj * 1024, 2 * 9216, wo ? 1.0f : 0.5f};
    if (EN_DOWN) pg8::gemm_phase(F.lds, g, S, E, F.tid);
}
__device__ __forceinline__ void ph_win(Frame& F) {
    CArgs& A = *get_args(); unsigned char* const ws = A.ws;
    pg8::Gemm g{(const pg8::bf16_t*)(ws + WS_XN), (const pg8::bf16_t*)(ws + WS_WINM), MTOK, NINM, DM};
    pg8::StaticOrder S; S.init(MTOK, NINM, F.G, F.bx);
    pg8::EpiWin E{(pg8::bf16_t*)(ws + WS_R1)};
    if (EN_WIN) pg8::gemm_phase(F.lds, g, S, E, F.tid);
}
__device__ __forceinline__ void ph_merge(Frame& F) {
    for (int b = 0; b < 3; ++b) {
        { CArgs& A = *get_args(); unsigned char* const ws = A.ws;
          pg8::Gemm g{(const pg8::bf16_t*)(ws + WS_XN), (const pg8::bf16_t*)(ws + WS_WG) + (size_t)b * DM * DM, MTOK, DM, DM};
          pg8::StaticOrder S; S.init(MTOK, DM, F.G, F.bx);
          pg8::EpiSig E{(pg8::bf16_t*)(ws + WS_GS), nullptr};
          if (EN_SIG) pg8::gemm_phase(F.lds, g, S, E, F.tid); }
        { CArgs& A = *get_args(); unsigned char* const ws = A.ws;
          pg8::bf16_t* R1 = (pg8::bf16_t*)(ws + WS_R1);
          const pg8::bf16_t* Ab = R1 + (b == 0 ? U_RQ : (b == 1 ? U_AQ : U_CB));
          pg8::Gemm g{Ab, (const pg8::bf16_t*)(ws + WS_WRO) + (size_t)b * DM * 512, MTOK, DM, 512};
          pg8::StaticOrder S; S.init(MTOK, DM, F.G, F.bx);
          pg8::EpiMerge E{(const pg8::bf16_t*)(ws + WS_GS), (float*)(ws + WS_T), R1 + U_MG, b};
          if (EN_MERGE) pg8::gemm_phase(F.lds, g, S, E, F.tid); }
    }
}
__device__ __forceinline__ void relaunder(Frame& F) {
    int t = threadIdx.x; asm volatile("" : "+v"(t)); F.tid = t; F.lane = t & 63; F.wave = __builtin_amdgcn_readfirstlane(t >> 6);
    int bx = blockIdx.x, G = gridDim.x; asm volatile("" : "+s"(bx), "+s"(G)); F.G = G; F.vcu = (G % 8 == 0) ? (bx % 8) * (G / 8) + bx / 8 : bx; F.bx = bx;
}
__device__ __forceinline__ void grid_barrier(Frame& F, unsigned bar_x) {
    CArgs* A2 = get_args();
    unsigned bxx = bar_x; asm volatile("" : "+s"(bxx));
    XcdBarrier bar; bar.bar = (unsigned*)(A2->ws + WS_CTL) + CW_BAR; bar.x = bxx; bar.st = (volatile LAS unsigned*)(F.lds + MISC_OFF) + 8;
    xcd_barrier(bar, F.tid);
}
#if TPROBE
#define TSTAMP(k) do { if (blockIdx.x == 0 && threadIdx.x == 0) { CArgs* A3 = get_args(); ((unsigned long long*)(A3->ws + WS_CTL + 65536))[(k) + 1] = __builtin_amdgcn_s_memrealtime(); } } while (0)
#else
#define TSTAMP(k) do { } while (0)
#endif
#define PHASE(k, ...) do { if (ph_lo <= (k) && (k) < ph_hi) { relaunder(F); __VA_ARGS__; if ((k) + 1 < ph_hi || TPROBE) grid_barrier(F, bar_x); TSTAMP(k); } } while (0)
#define LAYER(l, base) \
    PHASE((base) + 0, ph_ffn_up(F, 0)); \
    PHASE((base) + 1, ph_resid(F, l, 0, false)); \
    PHASE((base) + 2, modnorm_rows(F, l, 1, false)); \
    PHASE((base) + 3, ph_win(F)); \
    PHASE((base) + 4, if (EN_MIX1) { qk_pass(F, l); conv_pass(F, l); ret_pass1(F, l); }); \
    PHASE((base) + 5, ret_scan(F, l)); \
    PHASE((base) + 6, if (EN_RET3) ret_pass3(F, l); if (EN_ATTN) { if (USE_MFMA_ATTN) attn_mfma(F, l); else attn_naive(F, l); }); \
    PHASE((base) + 7, ph_merge(F)); \
    PHASE((base) + 8, ph_resid(F, l, 0, true)); \
    PHASE((base) + 9, modnorm_rows(F, l, 2, false)); \
    PHASE((base) + 10, ph_ffn_up(F, 1)); \
    PHASE((base) + 11, ph_resid(F, l, 1, false))

__global__ void __launch_bounds__(NWAVES * 64, 2) trunk_fwd(Args args_unused) {
    extern __shared__ __attribute__((aligned(16))) unsigned char lds[];
    Frame F;
    F.lds = (LAS unsigned char*)lds;
    { const int t0 = threadIdx.x; for (int u = t0; u < (LDS_BYTES - RING_BYTES) / 4; u += NWAVES * 64) ((LAS unsigned*)(F.lds + RING_BYTES))[u] = 0u; }
    __syncthreads();
    int ph_lo, ph_hi; { CArgs* A0 = get_args(); ph_lo = A0->ph_lo; ph_hi = A0->ph_hi; }
    unsigned bar_x = 0;
    if (ph_hi - ph_lo > 1) { CArgs* A0 = get_args(); XcdBarrier b0 = xcd_barrier_post((unsigned*)(A0->ws + WS_CTL) + CW_BAR, (volatile LAS unsigned*)(F.lds + MISC_OFF) + 8); bar_x = b0.x; }
#if TPROBE
    if (blockIdx.x == 0 && threadIdx.x == 0) { CArgs* A3 = get_args(); ((unsigned long long*)(A3->ws + WS_CTL + 65536))[0] = __builtin_amdgcn_s_memrealtime(); }
#endif
#if DBG
    if (ph_lo >= 1000) { relaunder(F); int kind, l, sub; decode_phase(ph_lo, kind, l, sub); if (kind == 99) { if (sub == 999) dbg_final(F); else dbg_checks(F, sub); } return; }
#endif
    PHASE(0, if (EN_PRO) { compute_mod(F); prologue_misc(F); __syncthreads(); convert_weights(F, 0); });
    PHASE(1, modnorm_rows(F, 0, 0, true));
    LAYER(0, 2);
    PHASE(14, convert_weights(F, 1); modnorm_rows(F, 1, 0, false));
    LAYER(1, 15);
#if TPROBE
    if (blockIdx.x == 0 && threadIdx.x == 0) { CArgs* A3 = get_args(); const unsigned long long* ts = (const unsigned long long*)(A3->ws + WS_CTL + 65536);
        float sum[12]; for (int k = 0; k < 12; ++k) sum[k] = 0.f; float tot = 0.f;
        for (int ph = 0; ph < N_PHASES; ++ph) { int kind, l, sub; decode_phase(ph, kind, l, sub); const float d = (float)(ts[ph + 1] - ts[ph]); tot += d; sum[kind < 12 ? kind : 11] += d; }
        const int ka = (TPROBE >> 4) & 15, kb = TPROBE & 15; const float pa = 100.f * sum[ka] / tot, pb = 100.f * sum[kb] / tot;
        int ia = (int)(pa * 0.5f + 0.5f) * 2; if (ia > 88) ia = 88; int ib = (int)(pb * 0.5f + 0.5f) * 2; if (ib > 30) ib = 30;
        float v = (float)(10 + ia) * 1e4f; for (int i = 0; i < ib; ++i) v *= 10.0f; A3->out[0] = v; }
#endif
}

extern "C" void kernel_launch(void* const* d_in, const int* in_sizes, int n_in, void* d_out, int out_size, void* d_ws, size_t ws_size, hipStream_t stream) {
    static int grid = 0;
    if (grid == 0) {
        if (n_in != 22 || out_size != OUT_TOTAL || ws_size < WS_END) { fprintf(stderr, "kernel_launch: unexpected shapes: n_in %d out %d ws %zu (need %zu)\n", n_in, out_size, ws_size, (size_t)WS_END); grid = -1; return; }
        int dev = 0, cus = 0;
        if (hipGetDevice(&dev) != hipSuccess || hipDeviceGetAttribute(&cus, hipDeviceAttributeMultiprocessorCount, dev) != hipSuccess) { grid = -1; return; }
        if (hipFuncSetAttribute((const void*)trunk_fwd, hipFuncAttributeMaxDynamicSharedMemorySize, LDS_BYTES) != hipSuccess) { fprintf(stderr, "kernel_launch: hipFuncSetAttribute failed\n"); grid = -1; return; }
        int per_cu = 0;
        if (hipOccupancyMaxActiveBlocksPerMultiprocessor(&per_cu, (const void*)trunk_fwd, NWAVES * 64, LDS_BYTES) != hipSuccess || per_cu < 1) fprintf(stderr, "kernel_launch: occupancy query says %d\n", per_cu);
        (void)hipGetLastError();
        grid = cus;
    }
    if (grid < 0) return;
    (void)hipMemsetAsync((char*)d_ws + WS_CTL, 0, CTL_ZERO_BYTES, stream);
    Args a{};
    for (int i = 0; i < 22; ++i) a.in[i] = (const float*)d_in[i];
    a.out = (float*)d_out; a.ws = (unsigned char*)d_ws;
#if MK_MULTI_LAUNCH
    for (int ph = 0; ph < N_PHASES; ++ph) {
#if DBG
        if (0) { a.ph_lo = 1041; a.ph_hi = a.ph_lo + 1; hipLaunchKernelGGL(trunk_fwd, dim3(grid), dim3(NWAVES * 64), LDS_BYTES, stream, a); }
        if (0) { a.ph_lo = 1030 + (ph == 9 ? 1 : 0); a.ph_hi = a.ph_lo + 1; hipLaunchKernelGGL(trunk_fwd, dim3(grid), dim3(NWAVES * 64), LDS_BYTES, stream, a); }
        if (ph == 9) { for (int st = 0; st < 6; ++st) { a.ph_lo = 3000 + st; a.ph_hi = a.ph_lo + 1; hipLaunchKernelGGL(trunk_fwd, dim3(grid), dim3(NWAVES * 64), LDS_BYTES, stream, a);
                if (st == 0) { a.ph_lo = 1040; a.ph_hi = a.ph_lo + 1; hipLaunchKernelGGL(trunk_fwd, dim3(grid), dim3(NWAVES * 64), LDS_BYTES, stream, a); } } continue; }
#endif
        a.ph_lo = ph; a.ph_hi = ph + 1; hipLaunchKernelGGL(trunk_fwd, dim3(grid), dim3(NWAVES * 64), LDS_BYTES, stream, a);
#if DBG
        static const int after[][2] = {{8, 0}, {8, 1}, {9, 2}, {9, 3}, {10, 4}, {11, 5}, {12, 6}, {12, 3}, {13, 7}, {14, 16 + 9}, {15, 16 + 10}, {18, 16 + 8}, {21, 16 + 0}, {21, 16 + 1}};
        { static const int aft[][2] = {{5, 8}, {8, 0}, {8, 1}, {9, 2}, {9, 3}, {10, 4}};
          for (unsigned c = 0; c < 0; ++c) if (aft[c][0] == ph) { a.ph_lo = 1000 + aft[c][1]; a.ph_hi = a.ph_lo + 1; hipLaunchKernelGGL(trunk_fwd, dim3(grid), dim3(NWAVES * 64), LDS_BYTES, stream, a); } }
        if (0) { a.ph_lo = 1011; a.ph_hi = 1012; hipLaunchKernelGGL(trunk_fwd, dim3(grid), dim3(NWAVES * 64), LDS_BYTES, stream, a); a.ph_lo = 1012; a.ph_hi = 1013; hipLaunchKernelGGL(trunk_fwd, dim3(grid), dim3(NWAVES * 64), LDS_BYTES, stream, a); }
        for (unsigned c = 0; c < 0 * sizeof(after) / sizeof(after[0]); ++c) if (after[c][0] == ph) { a.ph_lo = 1000 + after[c][1]; a.ph_hi = a.ph_lo + 1; hipLaunchKernelGGL(trunk_fwd, dim3(grid), dim3(NWAVES * 64), LDS_BYTES, stream, a); }
#endif
    }
#if DBG
    a.ph_lo = 1999; a.ph_hi = 2000; hipLaunchKernelGGL(trunk_fwd, dim3(grid), dim3(NWAVES * 64), LDS_BYTES, stream, a);
#endif
#else
    a.ph_lo = 0; a.ph_hi = N_PHASES;
    hipLaunchKernelGGL(trunk_fwd, dim3(grid), dim3(NWAVES * 64), LDS_BYTES, stream, a);
#endif
}
```

```cpp
#include <hip/hip_runtime.h>
#include <cstdio>
#include <cstdint>

#ifndef EN_UP
#define EN_UP 1
#endif
#ifndef EN_DOWN
#define EN_DOWN 1
#endif
#ifndef EN_WIN
#define EN_WIN 1
#endif
#ifndef EN_SIG
#define EN_SIG 1
#endif
#ifndef EN_MERGE
#define EN_MERGE 1
#endif
#ifndef EN_MIX1
#define EN_MIX1 1
#endif
#ifndef EN_RET3
#define EN_RET3 1
#endif
#ifndef EN_ATTN
#define EN_ATTN 1
#endif
#ifndef EN_PRO
#define EN_PRO 1
#endif
#ifndef TPROBE
#define TPROBE 0
#endif
#ifndef MK_MULTI_LAUNCH
#define MK_MULTI_LAUNCH 0
#endif

namespace pg8 {
#define PG8_LAS __attribute__((address_space(3)))
typedef unsigned short bf16_t;
typedef short bf16x8 __attribute__((ext_vector_type(8)));
typedef float f32x4 __attribute__((ext_vector_type(4)));
typedef unsigned u32x4 __attribute__((ext_vector_type(4)));
constexpr int BM = 256, BK = 64, HALF = 128, HTB = HALF * BK * 2, STAGE_BYTES = 8 * HTB, NXCD = 8, WGM = 8;

__host__ __device__ __forceinline__ int lds_byte(int r, int c) { const int st = (r >> 4) * 2 + (c >> 5), rr = r & 15, cc = c & 31, ob = rr * 64 + cc * 2; return st * 1024 + (ob ^ (((ob >> 9) & 1) << 5)); }
__host__ __device__ __forceinline__ void stage_rc(int b, int& R, int& C) { const int st = b / 1024, sb = b % 1024, swz = sb ^ (((sb >> 9) & 1) << 5); R = (st >> 1) * 16 + swz / 64; C = (st & 1) * 32 + (swz % 64) / 2; }
__host__ __device__ __forceinline__ int perm32(int rho) { const int n = rho >> 4, i = rho & 15; return 8 * (i >> 2) + 4 * n + (i & 3); }

struct Unit { int pm, pn; };
struct Gemm { const bf16_t* A; const bf16_t* Bt; int M, N, K; };

struct StaticOrder {
    int nM, nN, nwg, G, c;
    __host__ __device__ void init(int M, int N, int G_, int c_) { nM = M / BM; nN = N / BM; nwg = nM * nN; G = G_; c = c_; }
    __host__ __device__ bool next(int i, Unit& u) const {
        const long L = (long)i * G + c; if (L >= nwg) return false;
        int wgid = (int)L; { const int q = nwg / NXCD, r = nwg % NXCD, xcd = wgid % NXCD, off = wgid / NXCD; wgid = (xcd < r ? xcd * (q + 1) : r * (q + 1) + (xcd - r) * q) + off; }
        const int nig = WGM * nN, gid = wgid / nig, fm = gid * WGM, gsz = (nM - fm) < WGM ? (nM - fm) : WGM;
        u.pm = fm + ((wgid % nig) % gsz); u.pn = (wgid % nig) / gsz; return true;
    }
};

typedef float f32x2_t __attribute__((ext_vector_type(2))); typedef __bf16 bf16x2_t __attribute__((ext_vector_type(2)));
__device__ __forceinline__ unsigned cvt_pk_bf16(float lo, float hi) { f32x2_t v = {lo, hi}; bf16x2_t b = __builtin_convertvector(v, bf16x2_t); return __builtin_bit_cast(unsigned, b); }
__device__ __forceinline__ float sigmoid_f(float x) { return __builtin_amdgcn_rcpf(1.0f + __expf(-x)); }
__device__ __forceinline__ float silu_f(float x) { return x * sigmoid_f(x); }
__device__ __forceinline__ float bflo(unsigned w) { return __uint_as_float(w << 16); }
__device__ __forceinline__ float bfhi(unsigned w) { return __uint_as_float(w & 0xffff0000u); }

template <int ACT> struct EpiPair {
    static constexpr bool PERM = true;
    bf16_t* O; int ldo; int tile0;
    __device__ __forceinline__ void operator()(const f32x4 (&acc)[2][2][4][2], const Unit& u, int wr, int wc, int fr, int fq) const {
        const int row0 = u.pm * BM + wr * 64 + fr, col0 = (u.pn - tile0) * HALF + wc * 32 + 8 * fq;
#pragma unroll
        for (int ai = 0; ai < 2; ++ai)
#pragma unroll
            for (int m = 0; m < 4; ++m) {
                bf16_t* rowp = O + (size_t)(row0 + ai * HALF + m * 16) * ldo + col0;
                f32x4 g0 = acc[ai][0][m][0], g1 = acc[ai][0][m][1]; const f32x4 u0 = acc[ai][1][m][0], u1 = acc[ai][1][m][1];
                if (ACT == 1) {
#pragma unroll
                    for (int j = 0; j < 4; ++j) { g0[j] = silu_f(g0[j]); g1[j] = silu_f(g1[j]); }
                }
                g0 = g0 * u0; g1 = g1 * u1;
                u32x4 w; w.x = cvt_pk_bf16(g0[0], g0[1]); w.y = cvt_pk_bf16(g0[2], g0[3]); w.z = cvt_pk_bf16(g1[0], g1[1]); w.w = cvt_pk_bf16(g1[2], g1[3]);
                *(u32x4*)rowp = w;
            }
    }
};
struct EpiWin {
    static constexpr bool PERM = true;
    bf16_t* U;
    __device__ __forceinline__ void operator()(const f32x4 (&acc)[2][2][4][2], const Unit& u, int wr, int wc, int fr, int fq) const {
        const int pn = u.pn; const size_t MP = (size_t)16384 * 512;
        const int row0 = u.pm * BM + wr * 64 + fr;
        if (pn >= 13) {
            EpiPair<0> e{U + 5 * MP + (size_t)16384 * 256 + MP, 512, 13}; e(acc, u, wr, wc, fr, fq); return;
        }
        bf16_t* base; int ld = 512, ct;
        if (pn < 10) { base = U + (size_t)(pn >> 1) * MP; ct = (pn & 1) * 256; }
        else if (pn == 10) { base = U + 5 * MP; ld = 256; ct = 0; }
        else { base = U + 5 * MP + (size_t)16384 * 256; ct = (pn - 11) * 256; }
        const bool do_silu = (pn == 6 || pn == 7);
        const int col0 = ct + wc * 32 + 8 * fq;
#pragma unroll
        for (int ai = 0; ai < 2; ++ai)
#pragma unroll
            for (int m = 0; m < 4; ++m) {
                bf16_t* rowp = base + (size_t)(row0 + ai * HALF + m * 16) * ld + col0;
#pragma unroll
                for (int bj = 0; bj < 2; ++bj) {
                    f32x4 v0 = acc[ai][bj][m][0], v1 = acc[ai][bj][m][1];
                    if (do_silu) {
#pragma unroll
                        for (int j = 0; j < 4; ++j) { v0[j] = silu_f(v0[j]); v1[j] = silu_f(v1[j]); }
                    }
                    u32x4 w; w.x = cvt_pk_bf16(v0[0], v0[1]); w.y = cvt_pk_bf16(v0[2], v0[3]); w.z = cvt_pk_bf16(v1[0], v1[1]); w.w = cvt_pk_bf16(v1[2], v1[3]);
                    *(u32x4*)(rowp + bj * HALF) = w;
                }
            }
    }
};
struct EpiResid {
    static constexpr bool PERM = false;
    const float* base_lo; const float* base_hi; float* out; const float* gate; int gate_stride; float gs;
    __device__ __forceinline__ void operator()(const f32x4 (&acc)[2][2][4][2], const Unit& u, int wr, int wc, int fr, int fq) const {
        const int col0 = u.pn * BM + wc * 32 + 4 * fq;
        const int ci = u.pm < 32 ? 0 : (u.pm < 48 ? 1 : 2);
        const float* gp = gate + (size_t)ci * gate_stride + col0;
        f32x4 gv[2][2];
#pragma unroll
        for (int bj = 0; bj < 2; ++bj)
#pragma unroll
            for (int n = 0; n < 2; ++n) gv[bj][n] = *(const f32x4*)(gp + bj * HALF + n * 16) * gs;
        const float* bb = u.pm < 32 ? base_lo + (size_t)u.pm * BM * 1024 : base_hi + (size_t)(u.pm - 32) * BM * 1024;
        float* oo = out + (size_t)u.pm * BM * 1024;
#pragma unroll
        for (int ai = 0; ai < 2; ++ai)
#pragma unroll
            for (int m = 0; m < 4; ++m) {
                const size_t off = (size_t)(ai * HALF + wr * 64 + m * 16 + fr) * 1024 + col0;
#pragma unroll
                for (int bj = 0; bj < 2; ++bj)
#pragma unroll
                    for (int n = 0; n < 2; ++n) {
                        const f32x4 b = *(const f32x4*)(bb + off + bj * HALF + n * 16);
                        *(f32x4*)(oo + off + bj * HALF + n * 16) = b + gv[bj][n] * acc[ai][bj][m][n];
                    }
            }
    }
};
struct EpiSig {
    static constexpr bool PERM = true;
    bf16_t* GS; float* DBGT;
    __device__ __forceinline__ void operator()(const f32x4 (&acc)[2][2][4][2], const Unit& u, int wr, int wc, int fr, int fq) const {
        const int row0 = u.pm * BM + wr * 64 + fr, col0 = u.pn * BM + wc * 32 + 8 * fq;
        if (DBGT) { float* p = DBGT + (size_t)(row0 + HALF + 48) * 1024 + col0 + HALF; *(f32x4*)p = acc[1][1][3][0]; *(f32x4*)(p + 4) = acc[1][1][3][1]; }
#pragma unroll
        for (int ai = 0; ai < 2; ++ai)
#pragma unroll
            for (int m = 0; m < 4; ++m) {
                bf16_t* rowp = GS + (size_t)(row0 + ai * HALF + m * 16) * 1024 + col0;
#pragma unroll
                for (int bj = 0; bj < 2; ++bj) {
                    f32x4 v0 = acc[ai][bj][m][0], v1 = acc[ai][bj][m][1];
#pragma unroll
                    for (int j = 0; j < 4; ++j) { v0[j] = sigmoid_f(v0[j]); v1[j] = sigmoid_f(v1[j]); }
                    u32x4 w; w.x = cvt_pk_bf16(v0[0], v0[1]); w.y = cvt_pk_bf16(v0[2], v0[3]); w.z = cvt_pk_bf16(v1[0], v1[1]); w.w = cvt_pk_bf16(v1[2], v1[3]);
                    *(u32x4*)(rowp + bj * HALF) = w;
                }
            }
    }
};
struct EpiMerge {
    static constexpr bool PERM = true;
    const bf16_t* GS; float* T; bf16_t* MG; int mode;
    __device__ __forceinline__ void operator()(const f32x4 (&acc)[2][2][4][2], const Unit& u, int wr, int wc, int fr, int fq) const {
        const int row0 = u.pm * BM + wr * 64 + fr, col0 = u.pn * BM + wc * 32 + 8 * fq;
#pragma unroll
        for (int ai = 0; ai < 2; ++ai)
#pragma unroll
            for (int m = 0; m < 4; ++m) {
                const size_t ro = (size_t)(row0 + ai * HALF + m * 16) * 1024 + col0;
#pragma unroll
                for (int bj = 0; bj < 2; ++bj) {
                    const u32x4 g = *(const u32x4*)(GS + ro + bj * HALF);
                    f32x4 v0 = acc[ai][bj][m][0], v1 = acc[ai][bj][m][1];
                    v0[0] *= bflo(g.x); v0[1] *= bfhi(g.x); v0[2] *= bflo(g.y); v0[3] *= bfhi(g.y);
                    v1[0] *= bflo(g.z); v1[1] *= bfhi(g.z); v1[2] *= bflo(g.w); v1[3] *= bfhi(g.w);
                    float* tp = T + ro + bj * HALF;
                    if (mode != 0) { v0 = v0 + *(const f32x4*)tp; v1 = v1 + *(const f32x4*)(tp + 4); }
                    if (mode != 2) { *(f32x4*)tp = v0; *(f32x4*)(tp + 4) = v1; }
                    else { u32x4 w; w.x = cvt_pk_bf16(v0[0], v0[1]); w.y = cvt_pk_bf16(v0[2], v0[3]); w.z = cvt_pk_bf16(v1[0], v1[1]); w.w = cvt_pk_bf16(v1[2], v1[3]);
                           *(u32x4*)(MG + ro + bj * HALF) = w; }
                }
            }
    }
};

template <class Epi, class Sched>
__device__ __forceinline__ void gemm_phase(PG8_LAS unsigned char* lds, const Gemm g, const Sched& S, const Epi& E, const int tid) {
    const int wid = __builtin_amdgcn_readfirstlane(tid >> 6), lane = tid & 63, wr = wid >> 2, wc = wid & 3, fr = lane & 15, fq = lane >> 4;
    const int K = g.K, nt = K / BK;
    unsigned voffA[2], voffB[2];
#pragma unroll
    for (int i = 0; i < 2; ++i) { int R, C; stage_rc(tid * 16 + i * 8192, R, C); const int Rb = Epi::PERM ? ((R & ~31) + perm32(R & 31)) : R;
        voffA[i] = (unsigned)(R * K + C) * 2u; voffB[i] = (unsigned)(Rb * K + C) * 2u; }
    const size_t kstep = (size_t)(BK * 2);
    const size_t hstep = (size_t)HALF * K * 2;
    const size_t tstep = 2 * hstep;
    const unsigned ldsw = (unsigned)wid * 1024u;
    const int aoff = lds_byte(wr * 64 + fr, fq * 8), boff = lds_byte(wc * 32 + fr, fq * 8);
#define PG8_SA(b, h) (((b) * 2 + (h)) * HTB)
#define PG8_SB(b, h) ((4 + (b) * 2 + (h)) * HTB)
#define PG8_STAGE(bufoff, gbase, voff) do { _Pragma("unroll") for (int _i = 0; _i < 2; ++_i) \
        __builtin_amdgcn_global_load_lds((const unsigned*)((const char*)(gbase) + (voff)[_i]), (PG8_LAS unsigned*)(lds + (bufoff) + ldsw + _i * 8192), 16, 0, 0); } while (0)
#define PG8_LDA(dst, b, h) do { _Pragma("unroll") for (int m = 0; m < 4; ++m) _Pragma("unroll") for (int k = 0; k < 2; ++k) dst[m][k] = *(const PG8_LAS bf16x8*)(lds + PG8_SA(b, h) + aoff + m * 2048 + k * 1024); } while (0)
#define PG8_LDB(dst, b, h) do { _Pragma("unroll") for (int n = 0; n < 2; ++n) _Pragma("unroll") for (int k = 0; k < 2; ++k) dst[n][k] = *(const PG8_LAS bf16x8*)(lds + PG8_SB(b, h) + boff + n * 2048 + k * 1024); } while (0)
#define PG8_MMA(ai, bj, At, Bt) do { __builtin_amdgcn_s_setprio(1); _Pragma("unroll") for (int m = 0; m < 4; ++m) _Pragma("unroll") for (int n = 0; n < 2; ++n) _Pragma("unroll") for (int k = 0; k < 2; ++k) \
        acc[ai][bj][m][n] = __builtin_amdgcn_mfma_f32_16x16x32_bf16(Bt[n][k], At[m][k], acc[ai][bj][m][n], 0, 0, 0); __builtin_amdgcn_s_setprio(0); } while (0)
#define PG8_WAIT_V(n) asm volatile("s_waitcnt vmcnt(" #n ")" ::: "memory")
#define PG8_WAIT_L(n) asm volatile("s_waitcnt lgkmcnt(" #n ")" ::: "memory")
#define PG8_BAR __builtin_amdgcn_s_barrier()
#define PG8_SCHED __builtin_amdgcn_sched_barrier(0)
    Unit cur, nxt; int ui = 0;
    if (!S.next(0, cur)) return;
    f32x4 acc[2][2][4][2];
#pragma unroll
    for (int a = 0; a < 2; ++a)
#pragma unroll
        for (int b = 0; b < 2; ++b)
#pragma unroll
            for (int m = 0; m < 4; ++m)
#pragma unroll
                for (int n = 0; n < 2; ++n) acc[a][b][m][n] = (f32x4){0.f, 0.f, 0.f, 0.f};
    bf16x8 At[4][2], B0[2][2], B1[2][2];
    const char* cA = (const char*)g.A + (size_t)cur.pm * tstep; const char* cB = (const char*)g.Bt + (size_t)cur.pn * tstep;
    PG8_STAGE(PG8_SB(0, 0), cB, voffB); PG8_STAGE(PG8_SB(0, 1), cB + hstep, voffB); PG8_STAGE(PG8_SA(0, 0), cA, voffA); PG8_STAGE(PG8_SA(0, 1), cA + hstep, voffA);
    if (wr == 1) PG8_BAR;
    PG8_WAIT_V(2); PG8_BAR;
    PG8_STAGE(PG8_SB(1, 0), cB + kstep, voffB); PG8_STAGE(PG8_SA(1, 0), cA + kstep, voffA); PG8_STAGE(PG8_SB(1, 1), cB + hstep + kstep, voffB);
    PG8_WAIT_V(6); PG8_BAR;
    for (;;) {
        const bool has_next = S.next(ui + 1, nxt);
        const char* nA = has_next ? (const char*)g.A + (size_t)nxt.pm * tstep : cA; const char* nB = has_next ? (const char*)g.Bt + (size_t)nxt.pn * tstep : cB;
        for (int t = 0; t < nt; t += 2) {
            const bool last = (t == nt - 2);
            const char* a1 = cA + (size_t)(t + 1) * kstep;
            const char* a2 = last ? nA : cA + (size_t)(t + 2) * kstep; const char* b2 = last ? nB : cB + (size_t)(t + 2) * kstep;
            const char* a3 = a2 + kstep; const char* b3 = b2 + kstep;
            PG8_LDB(B0, 0, 0); PG8_LDB(B1, 0, 1); PG8_SCHED; PG8_LDA(At, 0, 0); PG8_STAGE(PG8_SA(1, 1), a1 + hstep, voffA);
            PG8_WAIT_V(8); PG8_WAIT_L(0); PG8_BAR; PG8_MMA(0, 0, At, B0); PG8_MMA(0, 1, At, B1); PG8_BAR; PG8_SCHED;
            PG8_LDA(At, 0, 1); PG8_STAGE(PG8_SB(0, 0), b2, voffB); PG8_STAGE(PG8_SB(0, 1), b2 + hstep, voffB); PG8_STAGE(PG8_SA(0, 0), a2, voffA);
            PG8_WAIT_V(8); PG8_WAIT_L(0); PG8_BAR; PG8_MMA(1, 0, At, B0); PG8_MMA(1, 1, At, B1); PG8_BAR; PG8_SCHED;
            PG8_LDB(B0, 1, 0); PG8_LDB(B1, 1, 1); PG8_SCHED; PG8_LDA(At, 1, 0); PG8_STAGE(PG8_SA(0, 1), a2 + hstep, voffA);
            PG8_WAIT_V(8); PG8_WAIT_L(0); PG8_BAR; PG8_MMA(0, 0, At, B0); PG8_MMA(0, 1, At, B1); PG8_BAR; PG8_SCHED;
            PG8_LDA(At, 1, 1); PG8_STAGE(PG8_SB(1, 0), b3, voffB); PG8_STAGE(PG8_SB(1, 1), b3 + hstep, voffB); PG8_STAGE(PG8_SA(1, 0), a3, voffA);
            PG8_WAIT_V(8); PG8_WAIT_L(0); PG8_BAR; PG8_MMA(1, 0, At, B0); PG8_MMA(1, 1, At, B1); PG8_BAR; PG8_SCHED;
        }
        if (wr == 0) PG8_BAR;
        E(acc, cur, wr, wc, fr, fq);
        if (!has_next) break;
#pragma unroll
        for (int a = 0; a < 2; ++a)
#pragma unroll
            for (int b = 0; b < 2; ++b)
#pragma unroll
                for (int m = 0; m < 4; ++m)
#pragma unroll
                    for (int n = 0; n < 2; ++n) acc[a][b][m][n] = (f32x4){0.f, 0.f, 0.f, 0.f};
        cur = nxt; cA = nA; cB = nB; ++ui;
        if (wr == 1) PG8_BAR;
    }
    PG8_WAIT_V(0);
    PG8_BAR;
#undef PG8_SA
#undef PG8_SB
#undef PG8_STAGE
#undef PG8_LDA
#undef PG8_LDB
#undef PG8_MMA
#undef PG8_WAIT_V
#undef PG8_WAIT_L
#undef PG8_BAR
#undef PG8_SCHED
}
}

#include <hip/hip_bf16.h>
#include <cmath>
namespace attn_body {
using bf16=__hip_bfloat16;
using bf16x8=__attribute__((ext_vector_type(8)))short;
using s16x4=__attribute__((ext_vector_type(4)))short;
using f32x16=__attribute__((ext_vector_type(16)))float;
using u32x4=__attribute__((ext_vector_type(4)))unsigned;
constexpr int D=64,QP=512,KP=64;
constexpr int NW=8,QBLK=32,QB=QBLK*NW,KVBLK=64;
constexpr int ATTN_UNIT_ROWS=QB;
__device__ __forceinline__ int crow(int r,int hi){return (r&3)+8*(r>>2)+4*hi;}
#define SBAR() __builtin_amdgcn_sched_barrier(0)
__device__ __forceinline__ void cmask(f32x16&p0,f32x16&p1,int jb,int qrel,int hi){
  const float NEG=-INFINITY; int kb=64*jb+4*hi;
  #pragma unroll
  for(int r=0;r<16;++r){int kv=kb+(r&3)+8*(r>>2); if(kv>qrel)p0[r]=NEG; if(kv+32>qrel)p1[r]=NEG;}
}

constexpr int NSLOT=3, SLOTB=8192;
constexpr int LDS_K=0, LDS_V=NSLOT*SLOTB, LDS_WS=2*NSLOT*SLOTB, LDS_OST=LDS_WS+NW*64*4, LDS_BYTES=LDS_OST+NW*4096;
constexpr float C2=0.125f*1.4426950408889634f;
__device__ __forceinline__ void glds16(const void*gsrc,unsigned lds_dst){unsigned keep;
  asm volatile("s_mov_b32 %0, m0\n\ts_mov_b32 m0, %2\n\ts_nop 0\n\tglobal_load_lds_dwordx4 %1, off\n\ts_mov_b32 m0, %0":"=&s"(keep):"v"(gsrc),"s"(lds_dst):"memory");}
__device__ __forceinline__ float max3f(float a,float b,float c){float r;asm("v_max3_f32 %0, %1, %2, %3":"=v"(r):"v"(a),"v"(b),"v"(c));return r;}
__device__ __forceinline__ float max2f(float a,float b){float r;asm("v_max_f32_e32 %0, %1, %2":"=v"(r):"v"(a),"v"(b));return r;}
__device__ __forceinline__ float fadd_s(float a,float b){float r;asm("v_add_f32_e32 %0, %1, %2":"=v"(r):"v"(a),"v"(b));return r;}
__device__ __forceinline__ float fsub_s(float a,float b){float r;asm("v_sub_f32_e32 %0, %1, %2":"=v"(r):"v"(a),"v"(b));return r;}
typedef float f32x2_t __attribute__((ext_vector_type(2))); typedef __bf16 bf16x2_t __attribute__((ext_vector_type(2)));
__device__ __forceinline__ unsigned cvtpk_s(float lo,float hi){f32x2_t v={lo,hi};bf16x2_t b=__builtin_convertvector(v,bf16x2_t);return __builtin_bit_cast(unsigned,b);}
#define WAIT_BAR(N) asm volatile("s_waitcnt vmcnt(" #N ") lgkmcnt(0)\n\ts_barrier":::"memory")

__device__ __forceinline__ void qkt(f32x16&p0,f32x16&p1,const char*Kslot,const bf16x8*qr,const f32x16&negm,int r32,int hi){
  const char*kb=Kslot+hi*1024+r32*16;
  #pragma unroll
  for(int d0=0;d0<4;++d0){
    const bf16x8 b0=*reinterpret_cast<const bf16x8*>(kb+d0*2048);
    const bf16x8 b1=*reinterpret_cast<const bf16x8*>(kb+d0*2048+512);
    if(d0==0){p0=__builtin_amdgcn_mfma_f32_32x32x16_bf16(b0,qr[0],negm,0,0,0);p1=__builtin_amdgcn_mfma_f32_32x32x16_bf16(b1,qr[0],negm,0,0,0);}
    else{p0=__builtin_amdgcn_mfma_f32_32x32x16_bf16(b0,qr[d0],p0,0,0,0);p1=__builtin_amdgcn_mfma_f32_32x32x16_bf16(b1,qr[d0],p1,0,0,0);}}
}
typedef __attribute__((address_space(3))) const char* lds_cptr;
typedef short v4i16_t __attribute__((ext_vector_type(4)));
__device__ __forceinline__ void kload8(bf16x8*kf,lds_cptr kp){
  kf[0]=*(const __attribute__((address_space(3))) bf16x8*)(kp);      kf[1]=*(const __attribute__((address_space(3))) bf16x8*)(kp+512);
  kf[2]=*(const __attribute__((address_space(3))) bf16x8*)(kp+2048); kf[3]=*(const __attribute__((address_space(3))) bf16x8*)(kp+2560);
  kf[4]=*(const __attribute__((address_space(3))) bf16x8*)(kp+4096); kf[5]=*(const __attribute__((address_space(3))) bf16x8*)(kp+4608);
  kf[6]=*(const __attribute__((address_space(3))) bf16x8*)(kp+6144); kf[7]=*(const __attribute__((address_space(3))) bf16x8*)(kp+6656);
}
__device__ __forceinline__ void kload2(bf16x8*kf,lds_cptr kp,int j){ kf[2*j]=*(const __attribute__((address_space(3))) bf16x8*)(kp+j*2048); kf[2*j+1]=*(const __attribute__((address_space(3))) bf16x8*)(kp+j*2048+512); }
__device__ __forceinline__ s16x4 vtr(lds_cptr p){ return __builtin_bit_cast(s16x4,__builtin_amdgcn_ds_read_tr16_b64_v4i16((__attribute__((address_space(3))) v4i16_t*)p)); }
__device__ __forceinline__ float rowmax(const f32x16&p0,const f32x16&p1){
  float a=max3f(p0[0],p0[1],p1[0]),b=max3f(p0[2],p0[3],p1[1]);a=max3f(a,p1[2],p1[3]);
  #pragma unroll
  for(int r=4;r<16;r+=4){a=max3f(a,p0[r],p0[r+1]);b=max3f(b,p0[r+2],p0[r+3]);a=max3f(a,p1[r],p1[r+1]);b=max3f(b,p1[r+2],p1[r+3]);}
  const float m=max2f(a,b);
  auto rr=__builtin_amdgcn_permlane32_swap(__float_as_uint(m),__float_as_uint(m),false,false);
  return max2f(__uint_as_float(rr[0]),__uint_as_float(rr[1]));
}
__device__ __forceinline__ void pv(f32x16*o,int vb,bf16x8 pa0,bf16x8 pa1,bf16x8 pa2,bf16x8 pa3){
  #pragma unroll
  for(int d0=0;d0<2;++d0){s16x4 lo[4],hi[4];
    #pragma unroll
    for(int ks=0;ks<4;++ks){
      asm volatile("ds_read_b64_tr_b16 %0,%1 offset:%c2":"=&v"(lo[ks]):"v"(vb),"i"(d0*4096+ks*1024):"memory");
      asm volatile("ds_read_b64_tr_b16 %0,%1 offset:%c2":"=&v"(hi[ks]):"v"(vb),"i"(d0*4096+ks*1024+512):"memory");}
    asm volatile("s_waitcnt lgkmcnt(0)":::"memory");SBAR();
    #define PK(k) (bf16x8){lo[k][0],lo[k][1],lo[k][2],lo[k][3],hi[k][0],hi[k][1],hi[k][2],hi[k][3]}
    o[d0]=__builtin_amdgcn_mfma_f32_32x32x16_bf16(pa0,PK(0),o[d0],0,0,0);
    o[d0]=__builtin_amdgcn_mfma_f32_32x32x16_bf16(pa1,PK(1),o[d0],0,0,0);
    o[d0]=__builtin_amdgcn_mfma_f32_32x32x16_bf16(pa2,PK(2),o[d0],0,0,0);
    o[d0]=__builtin_amdgcn_mfma_f32_32x32x16_bf16(pa3,PK(3),o[d0],0,0,0);
    #undef PK
  }
}

#ifndef ATTN_STORE16
#define ATTN_STORE16(p,v) (*(u32x4*)(p)=(v))
#endif
template<int THRL> __device__ __forceinline__ void attn_unit(const bf16*Qu,const bf16*__restrict__ Kh,const bf16*__restrict__ Vh,bf16*Ou,const int NT,char*shm,const int tid){
  const int lane=tid&63,r32=lane&31,hi=lane>>5; const int wid=__builtin_amdgcn_readfirstlane(tid>>6);
  const bf16*Qw=Qu+(long)(wid*QBLK)*QP;
  const unsigned lds0=(unsigned)(uintptr_t)shm;
  float*wsf=(float*)(shm+LDS_WS)+wid*64;
  const bf16*ksrc=Kh+(long)lane*KP+wid*8;
  const bf16*vsrc=Vh+(long)(16*(wid&3)+(lane>>2))*KP+(wid>>2)*32+(lane&3)*8;
  const unsigned kdst=lds0+LDS_K+wid*1024, vdst=lds0+LDS_V+wid*1024;
  #define DMA_K(t,slot) glds16(ksrc+(long)(t)*KVBLK*KP,(unsigned)__builtin_amdgcn_readfirstlane(kdst+(slot)))
  #define DMA_V(t,slot) glds16(vsrc+(long)(t)*KVBLK*KP,(unsigned)__builtin_amdgcn_readfirstlane(vdst+(slot)))
  const int vb0=(int)(lds0+LDS_V)+((lane>>4)&1)*32+(lane&3)*8+(4*hi+((lane&15)>>2))*64;
  const char*Kbase=shm+LDS_K; bf16x8 kf[8];
  const lds_cptr shm3=(lds_cptr)shm; const lds_cptr kp0=shm3+LDS_K+hi*1024+r32*16; const lds_cptr vp0=shm3+LDS_V+((lane>>4)&1)*32+(lane&3)*8+(4*hi+((lane&15)>>2))*64;
  DMA_K(0,0);DMA_V(0,0);DMA_K(1,SLOTB);
  bf16x8 qr[4];
  #pragma unroll
  for(int d0=0;d0<4;++d0)qr[d0]=*reinterpret_cast<const bf16x8*>(&Qw[(long)r32*QP+d0*16+hi*8]);
  float mhat=0.f,l_reg=0.f;f32x16 o[2];o[0]=f32x16{};o[1]=f32x16{};f32x16 negm=f32x16{};asm volatile("":"+v"(negm));
  #define CMASK(P0,P1,t) do{}while(0)
  bool resc=false;
  #define START(P0,P1) do{ const float rm=rowmax(P0,P1); resc=false; \
    { const float dl=rm; mhat=fadd_s(mhat,dl); \
      _Pragma("unroll") for(int r=0;r<16;++r){P0[r]=fsub_s(P0[r],dl);P1[r]=fsub_s(P1[r],dl);} \
      _Pragma("unroll") for(int r=0;r<16;++r)negm[r]=-mhat; asm volatile("":"+v"(negm)); } \
    _Pragma("unroll") for(int r=0;r<16;++r)P0[r]=__builtin_amdgcn_exp2f(P0[r]); }while(0)
  #define RESC() do{ if(resc){ asm volatile("s_waitcnt lgkmcnt(0)":::"memory"); \
      _Pragma("unroll") for(int d_=0;d_<2;++d_) _Pragma("unroll") for(int r=0;r<16;++r)o[d_][r]*=wsf[crow(r,hi)]; } }while(0)
  f32x16 pA0,pA1,pB0,pB1;
  int sl_prev=0,sl_cur=0,sl_next=SLOTB;
  #define ROT() do{sl_prev=sl_cur;sl_cur=sl_next;sl_next=(sl_next==(NSLOT-1)*SLOTB)?0:sl_next+SLOTB;}while(0)
  DMA_K(2,2*SLOTB);
  WAIT_BAR(3);
  qkt(pA0,pA1,Kbase,qr,negm,r32,hi);asm volatile("s_nop 15\n\ts_nop 7":"+v"(pA0),"+v"(pA1));CMASK(pA0,pA1,0);
  START(pA0,pA1);
  _Pragma("unroll") for(int r=0;r<16;++r)pA1[r]=__builtin_amdgcn_exp2f(pA1[r]);
  WAIT_BAR(0);
  DMA_K(3,0);DMA_V(1,SLOTB);
  ROT();
  kload8(kf,kp0+sl_cur);
  WAIT_BAR(2);
  s16x4 vlo[8],vhi[8]; u32x4 pw0,pw1,pw2,pw3;
  #define PKW(P,B) cvtpk_s(P[B],P[B+1])
  #define PAF(k) __builtin_bit_cast(bf16x8,pw##k)
  #define VFR(i) (bf16x8){vlo[i][0],vlo[i][1],vlo[i][2],vlo[i][3],vhi[i][0],vhi[i][1],vhi[i][2],vhi[i][3]}
  #define PIN(x) asm volatile("":"+v"(x))
  #define MX3(a,b,c) __builtin_fmaxf(__builtin_fmaxf((a),(b)),(c))
  #define GAPA(MF,A0,A1,A2,A3,W0,W1,PW) do{ MF; sacc+=A0; sacc+=A1; sacc+=A2; sacc+=A3; PIN(sacc); W0; W1; PIN(PW); SBAR(); }while(0)
  #define EX(v) __builtin_amdgcn_exp2f(v)
  #define GAPB(MF,X,B) do{ MF; X[B]=EX(X[B]); X[B+1]=EX(X[B+1]); X[B+2]=EX(X[B+2]); X[B+3]=EX(X[B+3]); PIN(X); SBAR(); }while(0)
  #define VRD(i) do{ vlo[i]=vtr(vp_+(((i)>>2)*4096+((i)&3)*1024)); vhi[i]=vtr(vp_+(((i)>>2)*4096+((i)&3)*1024+512)); }while(0)
  #define KRD(G,j) do{ if(G){ kload2(kf,kp0+sl_next,j); SBAR(); } }while(0)
  #define STEP(C0,C1,P0,P1,t,GK,GV,GL) do{ SBAR(); \
    const lds_cptr vp_=vp0+sl_prev; \
    VRD(0); SBAR(); float sacc=(P0[0]+P0[1]); \
    GAPA(C0=__builtin_amdgcn_mfma_f32_32x32x16_bf16(kf[0],qr[0],negm,0,0,0), P0[2],P0[3],P0[4],P0[5],     pw0[0]=PKW(P0,0), pw0[1]=PKW(P0,2), pw0); \
    VRD(4); SBAR(); GAPA(C1=__builtin_amdgcn_mfma_f32_32x32x16_bf16(kf[1],qr[0],negm,0,0,0), P0[6],P0[7],P0[8],P0[9],     pw0[2]=PKW(P0,4), pw0[3]=PKW(P0,6), pw0); \
    VRD(1); SBAR(); GAPA(C0=__builtin_amdgcn_mfma_f32_32x32x16_bf16(kf[2],qr[1],C0,0,0,0),   P0[10],P0[11],P0[12],P0[13], pw1[0]=PKW(P0,8), pw1[1]=PKW(P0,10), pw1); \
    VRD(5); SBAR(); GAPA(C1=__builtin_amdgcn_mfma_f32_32x32x16_bf16(kf[3],qr[1],C1,0,0,0),   P0[14],P0[15],P1[0],P1[1],   pw1[2]=PKW(P0,12),pw1[3]=PKW(P0,14), pw1); \
    VRD(2); SBAR(); GAPA(C0=__builtin_amdgcn_mfma_f32_32x32x16_bf16(kf[4],qr[2],C0,0,0,0),   P1[2],P1[3],P1[4],P1[5],     pw2[0]=PKW(P1,0), pw2[1]=PKW(P1,2), pw2); \
    VRD(6); SBAR(); GAPA(C1=__builtin_amdgcn_mfma_f32_32x32x16_bf16(kf[5],qr[2],C1,0,0,0),   P1[6],P1[7],P1[8],P1[9],     pw2[2]=PKW(P1,4), pw2[3]=PKW(P1,6), pw2); \
    VRD(3); SBAR(); GAPA(C0=__builtin_amdgcn_mfma_f32_32x32x16_bf16(kf[6],qr[3],C0,0,0,0),   P1[10],P1[11],P1[12],P1[13], pw3[0]=PKW(P1,8), pw3[1]=PKW(P1,10), pw3); \
    VRD(7); SBAR(); GAPA(C1=__builtin_amdgcn_mfma_f32_32x32x16_bf16(kf[7],qr[3],C1,0,0,0),   P1[14],P1[15],0.f,0.f,       pw3[2]=PKW(P1,12),pw3[3]=PKW(P1,14), pw3); \
    l_reg+=sacc; \
    if(GK){DMA_K((t)+3,sl_cur);} if(GV){DMA_V((t)+1,sl_next);} \
    CMASK(C0,C1,t); \
    { float a=MX3(C0[0],C0[1],C1[0]),b=MX3(C0[2],C0[3],C1[1]); a=MX3(a,C1[2],C1[3]); \
      _Pragma("unroll") for(int r=4;r<16;r+=4){a=MX3(a,C0[r],C0[r+1]);b=MX3(b,C0[r+2],C0[r+3]);a=MX3(a,C1[r],C1[r+1]);b=MX3(b,C1[r+2],C1[r+3]);} \
      float rm=__builtin_fmaxf(a,b); { auto rr=__builtin_amdgcn_permlane32_swap(__float_as_uint(rm),__float_as_uint(rm),false,false); rm=__builtin_fmaxf(__uint_as_float(rr[0]),__uint_as_float(rr[1])); } \
      resc=false; \
      if(__builtin_expect(__any(rm>(float)THRL),0)){ const float dl=__builtin_fmaxf(rm,0.f); mhat+=dl; \
        _Pragma("unroll") for(int r=0;r<16;++r){C0[r]-=dl;C1[r]-=dl;} \
        _Pragma("unroll") for(int r=0;r<16;++r)negm[r]=-mhat; asm volatile("":"+v"(negm)); \
        const float f=__builtin_amdgcn_exp2f(-dl); l_reg*=f; if(hi==0)wsf[r32]=f; resc=true; } } \
    SBAR(); \
    GAPB(o[0]=__builtin_amdgcn_mfma_f32_32x32x16_bf16(PAF(0),VFR(0),o[0],0,0,0), C0,0); \
    GAPB(o[1]=__builtin_amdgcn_mfma_f32_32x32x16_bf16(PAF(0),VFR(4),o[1],0,0,0), C0,4); \
    KRD(GL,0); GAPB(o[0]=__builtin_amdgcn_mfma_f32_32x32x16_bf16(PAF(1),VFR(1),o[0],0,0,0), C0,8); \
    KRD(GL,1); GAPB(o[1]=__builtin_amdgcn_mfma_f32_32x32x16_bf16(PAF(1),VFR(5),o[1],0,0,0), C0,12); \
    KRD(GL,2); GAPB(o[0]=__builtin_amdgcn_mfma_f32_32x32x16_bf16(PAF(2),VFR(2),o[0],0,0,0), C1,0); \
    KRD(GL,3); GAPB(o[1]=__builtin_amdgcn_mfma_f32_32x32x16_bf16(PAF(2),VFR(6),o[1],0,0,0), C1,4); \
    GAPB(o[0]=__builtin_amdgcn_mfma_f32_32x32x16_bf16(PAF(3),VFR(3),o[0],0,0,0), C1,8); \
    GAPB(o[1]=__builtin_amdgcn_mfma_f32_32x32x16_bf16(PAF(3),VFR(7),o[1],0,0,0), C1,12); \
    }while(0)
  int t=1;
  #undef CMASK
  #define CMASK(P0,P1,t) do{}while(0)
  for(;t+5<NT;t+=2){
    STEP(pB0,pB1,pA0,pA1,t,true,true,true);     WAIT_BAR(2); RESC(); ROT();
    STEP(pA0,pA1,pB0,pB1,t+1,true,true,true);   WAIT_BAR(2); RESC(); ROT();
  }
  #undef CMASK
  #define CMASK(P0,P1,t) do{}while(0)
  #define ENDW(tt) do{ if((tt)+3<NT){WAIT_BAR(2);} else if((tt)+2<NT){WAIT_BAR(1);} else {WAIT_BAR(0);} }while(0)
  for(;t+1<NT;t+=2){
    STEP(pB0,pB1,pA0,pA1,t,(t+3<NT),(t+1<NT),(t+1<NT));       ENDW(t);   RESC(); ROT();
    STEP(pA0,pA1,pB0,pB1,t+1,(t+4<NT),(t+2<NT),(t+2<NT));     ENDW(t+1); RESC(); ROT();
  }
  STEP(pB0,pB1,pA0,pA1,NT-1,false,false,false); RESC();
  { float sacc=pB0[0]+pB0[1]; _Pragma("unroll") for(int r=2;r<16;++r)sacc+=pB0[r]; _Pragma("unroll") for(int r=0;r<16;++r)sacc+=pB1[r]; l_reg+=sacc;
    pw0=(u32x4){PKW(pB0,0),PKW(pB0,2),PKW(pB0,4),PKW(pB0,6)};pw1=(u32x4){PKW(pB0,8),PKW(pB0,10),PKW(pB0,12),PKW(pB0,14)};pw2=(u32x4){PKW(pB1,0),PKW(pB1,2),PKW(pB1,4),PKW(pB1,6)};pw3=(u32x4){PKW(pB1,8),PKW(pB1,10),PKW(pB1,12),PKW(pB1,14)};
    SBAR(); pv(o,vb0+sl_cur,PAF(0),PAF(1),PAF(2),PAF(3)); }
  #undef PKW
  #undef PAF
  #undef VFR
  #undef PIN
  #undef MX3
  #undef GAPA
  #undef GAPB
  #undef EX
  #undef VRD
  #undef KRD
  #undef STEP
  #undef ENDW
  {auto rr=__builtin_amdgcn_permlane32_swap(__float_as_uint(l_reg),__float_as_uint(l_reg),false,false);l_reg=__uint_as_float(rr[0])+__uint_as_float(rr[1]);}
  if(hi==0)wsf[32+r32]=l_reg;asm volatile("s_waitcnt lgkmcnt(0)":::"memory");
  float rli[16];
  #pragma unroll
  for(int r=0;r<16;++r)rli[r]=__builtin_amdgcn_rcpf(wsf[32+crow(r,hi)]);
  bf16*Ow=Ou+(long)(wid*QBLK)*QP;
  { bf16*stg=(bf16*)(shm+LDS_OST)+wid*2048;
    #pragma unroll
    for(int r=0;r<16;++r){const int orow=crow(r,hi);
      #pragma unroll
      for(int d0=0;d0<2;++d0)stg[orow*64+d0*32+r32]=__float2bfloat16(o[d0][r]*rli[r]);}
    asm volatile("s_waitcnt lgkmcnt(0)":::"memory");
    #pragma unroll
    for(int i=0;i<4;++i){const int row=i*8+(lane>>3),ch=lane&7; const u32x4 v=*(const u32x4*)(stg+row*64+ch*8); ATTN_STORE16(Ow+(long)row*QP+ch*8,v);} }
  asm volatile("s_waitcnt lgkmcnt(0)\n\ts_barrier":::"memory");
  #undef DMA_K
  #undef DMA_V
  #undef CMASK
  #undef START
  #undef RESC
  #undef ROT
}
constexpr int ATTN_LDS_BYTES=LDS_BYTES;
#undef SBAR
#undef WAIT_BAR
}

constexpr int NWAVES = 8;
constexpr int DM = 1024, MTOK = 16384, MCTX = 8192, FFN = 2816, NFF1 = 5632, NINM = 4352, NGATE = 3072, NIN_SRC = 7424;
constexpr int DEPTH = 2, SEQC = 256, SEQL = 4096, PAST = 512, SKL = PAST + SEQL;
constexpr float EPS = 1e-6f;
constexpr int OUT_STATE = 16777216, OUT_CK = 25165824, OUT_CV = 27262976, OUT_TOTAL = 29360128;

constexpr size_t MiB = 1u << 20;
constexpr size_t WS_CTL = 0, CTL_ZERO_BYTES = 1 * MiB;
constexpr size_t WS_MOD = 1 * MiB;
constexpr size_t WS_ROPE = WS_MOD + 256 * 1024;
constexpr size_t WS_WFF1 = 2 * MiB;
constexpr size_t WS_WFF2 = 24 * MiB;
constexpr size_t WS_WINM = 35 * MiB;
constexpr size_t WS_WG = WS_WINM + 8 * MiB + 512 * 1024;
constexpr size_t WS_WRO = WS_WG + 6 * MiB;
constexpr size_t WS_WO = WS_WRO + 3 * MiB;
constexpr size_t WS_KL = 55 * MiB;
constexpr size_t WS_VL = WS_KL + 4 * MiB + 512 * 1024;
constexpr size_t WS_KC = WS_VL + 4 * MiB + 512 * 1024;
constexpr size_t WS_VC = WS_KC + 2 * MiB;
constexpr size_t WS_XN = 68 * MiB;
constexpr size_t WS_R1 = 100 * MiB;
constexpr size_t WS_GS = 220 * MiB;
constexpr size_t WS_T = 252 * MiB;
constexpr size_t WS_END = 316 * MiB;
constexpr size_t PLANE = (size_t)MTOK * 512;
constexpr size_t U_RQ = 0, U_RK = PLANE, U_RV = 2 * PLANE, U_SRG = 3 * PLANE, U_AQ = 4 * PLANE, U_AKV = 5 * PLANE, U_CB = 5 * PLANE + (size_t)MTOK * 256, U_P = U_CB + PLANE;
constexpr size_t U_MG = U_RK;
constexpr int CW_BAR = 4096;

constexpr int RING_BYTES = 131072, LDS_BYTES = 163840, MISC_OFF = LDS_BYTES - 256;

#define GAS __attribute__((address_space(1)))
#define LAS __attribute__((address_space(3)))
typedef unsigned short bf16;
typedef unsigned v4u __attribute__((ext_vector_type(4)));
typedef float f32x4 __attribute__((ext_vector_type(4)));
#define RLX_AGENT __ATOMIC_RELAXED, __HIP_MEMORY_SCOPE_AGENT
__device__ __forceinline__ unsigned f2bf(float f) { unsigned u = __builtin_bit_cast(unsigned, f); return (u + 0x7fffu + ((u >> 16) & 1u)) >> 16; }
__device__ __forceinline__ unsigned pk2(float lo, float hi) { return f2bf(lo) | (f2bf(hi) << 16); }
__device__ __forceinline__ float bf2f(unsigned short h) { return __uint_as_float(((unsigned)h) << 16); }
__device__ __forceinline__ float blo(unsigned w) { return __uint_as_float(w << 16); }
__device__ __forceinline__ float bhi(unsigned w) { return __uint_as_float(w & 0xffff0000u); }
__device__ __forceinline__ float fexp2(float x) { return __builtin_amdgcn_exp2f(x); }
__device__ __forceinline__ float fexp(float x) { return __builtin_amdgcn_exp2f(x * 1.4426950408889634f); }
__device__ __forceinline__ float frsq(float x) { return __builtin_amdgcn_rsqf(x); }

#define XB_TMO      128
#define XB_XCNT(j)  (256  + 64 * (j))
#define XB_XSUB(j)  (1280 + 64 * (j))
#define XB_XGEN(j)  (2304 + 64 * (j))
#define XB_TOP      3328
#define XB_TOPGEN   3392
#define XCD_BAR_WORDS 3456
#define XB_SPIN_CAP (1u << 18)
__device__ __forceinline__ unsigned xb_ld(unsigned* p)              { return __hip_atomic_load(p, __ATOMIC_RELAXED, __HIP_MEMORY_SCOPE_AGENT); }
__device__ __forceinline__ unsigned xb_add(unsigned* p, unsigned v) { return __hip_atomic_fetch_add(p, v, __ATOMIC_RELAXED, __HIP_MEMORY_SCOPE_AGENT); }
__device__ __forceinline__ unsigned xb_xcc_id() { return (unsigned)__builtin_amdgcn_s_getreg((3 << 11) | 20) & 0xFu; }
#define XB_SPIN(cond, bar) do { unsigned _sp = 0; while (cond) { __builtin_amdgcn_s_sleep(1); \
    if ((++_sp & 255u) == 0u) { if (xb_ld(&(bar)[XB_TMO])) break; if (_sp > XB_SPIN_CAP) { atomicAdd(&(bar)[XB_TMO], 1u); break; } } } } while (0)
struct XcdBarrier { unsigned* bar; unsigned x; volatile LAS unsigned* st; };
__device__ __forceinline__ XcdBarrier xcd_barrier_post(unsigned* bar, volatile LAS unsigned* st) {
    XcdBarrier b; b.bar = bar; b.x = xb_xcc_id(); b.st = st;
    if (threadIdx.x == 0) (void)xb_add(&bar[XB_XCNT(b.x)], 1u);
    return b;
}
__device__ __forceinline__ void xcd_barrier_complete(unsigned* bar, unsigned x, unsigned& nloc, unsigned& nx) {
    const unsigned G = gridDim.x * gridDim.y * gridDim.z;
    unsigned sum, cnt, mine, sp = 0u;
    for (;;) {
        sum = 0u; cnt = 0u; mine = 0u;
#pragma unroll
        for (unsigned j = 0; j < 16; ++j) { const unsigned c = xb_ld(&bar[XB_XCNT(j)]); sum += c; cnt += (c > 0u) ? 1u : 0u; mine = (j == x) ? c : mine; }
        if (sum == G) break;
        __builtin_amdgcn_s_sleep(1);
        if ((++sp & 255u) == 0u) { if (xb_ld(&bar[XB_TMO])) break; if (sp > XB_SPIN_CAP) { atomicAdd(&bar[XB_TMO], 1u); break; } }
    }
    nloc = mine > 0u ? mine : 1u; nx = cnt > 0u ? cnt : 1u;
}
__device__ __forceinline__ void xcd_barrier(const XcdBarrier& b, const int tid) {
    asm volatile("s_waitcnt vmcnt(0)" ::: "memory");
    __syncthreads();
    if (tid == 0) {
        unsigned* bar = b.bar;
        __builtin_amdgcn_s_waitcnt(0);
        unsigned nloc = b.st[0], nx = b.st[1];
        if (nloc == 0u) { xcd_barrier_complete(bar, b.x, nloc, nx); b.st[0] = nloc; b.st[1] = nx; }
        const unsigned old = xb_add(&bar[XB_XSUB(b.x)], 1u);
        const unsigned gen = old / nloc;
        if (old + 1u == (gen + 1u) * nloc) {
            __builtin_amdgcn_fence(__ATOMIC_RELEASE, "agent");
            asm volatile("s_waitcnt vmcnt(0)" ::: "memory");
            const unsigned og = xb_add(&bar[XB_TOP], 1u);
            const unsigned tg = og / nx;
            if (og + 1u == (tg + 1u) * nx) xb_add(&bar[XB_TOPGEN], 1u);
            else XB_SPIN(xb_ld(&bar[XB_TOPGEN]) == tg, bar);
            __builtin_amdgcn_fence(__ATOMIC_ACQUIRE, "agent");
            xb_add(&bar[XB_XGEN(b.x)], 1u);
            asm volatile("s_waitcnt vmcnt(0)" ::: "memory");
        } else {
            XB_SPIN(xb_ld(&bar[XB_XGEN(b.x)]) == gen, bar);
            __builtin_amdgcn_fence(__ATOMIC_ACQUIRE, "agent");
            asm volatile("s_waitcnt vmcnt(0)" ::: "memory");
        }
    }
    __syncthreads();
}

struct Args { const float* in[22]; float* out; unsigned char* ws; int ph_lo, ph_hi; };
enum { I_XP = 0, I_XS, I_C, I_STATE, I_CK, I_CV, I_CCTX, I_WADA, I_BADA, I_NORMW, I_WFFIN, I_WFFOUT, I_WIN, I_DECAY, I_RETGN, I_QG, I_KG, I_CONVW, I_WRO, I_WAO, I_WCO, I_WO };

typedef const Args __attribute__((address_space(4))) CArgs;
__device__ __forceinline__ CArgs* get_args() { CArgs* p = (CArgs*)__builtin_amdgcn_kernarg_segment_ptr(); asm volatile("" : "+s"(p)); return p; }
struct Frame {
    LAS unsigned char* lds;
    int tid, lane, wave, vcu, G, bx;
};
__device__ __forceinline__ int cond_of_row(int m) { return m < MCTX ? 0 : (m < MCTX + SEQL ? 1 : 2); }
__device__ __forceinline__ float wave_sum(float v) {
#pragma unroll
    for (int o = 1; o < 64; o <<= 1) v += __shfl_xor(v, o);
    return v;
}

__device__ __forceinline__ void transpose_item(const float* W, int K, int srcN, int src_col0, bf16* WT, int dst_row0, int k0, LAS float* scr, int lane) {
#pragma unroll 8
    for (int i = 0; i < 32; ++i) { const int kk = 2 * i + (lane >> 5); scr[kk * 33 + (lane & 31)] = W[(size_t)(k0 + kk) * srcN + src_col0 + (lane & 31)]; }
    asm volatile("s_waitcnt lgkmcnt(0)" ::: "memory");
    const int c = lane & 7;
#pragma unroll
    for (int j = 0; j < 4; ++j) { const int n = (lane >> 3) + 8 * j; const LAS float* s = scr + (8 * c) * 33 + n;
        v4u o; o.x = pk2(s[0 * 33], s[1 * 33]); o.y = pk2(s[2 * 33], s[3 * 33]); o.z = pk2(s[4 * 33], s[5 * 33]); o.w = pk2(s[6 * 33], s[7 * 33]);
        *(GAS v4u*)(WT + (size_t)(dst_row0 + n) * K + k0 + 8 * c) = o; }
    asm volatile("s_waitcnt lgkmcnt(0)" ::: "memory");
}
__device__ __forceinline__ void convert_weights(Frame& F, int l) {
    LAS float* scr = (LAS float*)(F.lds + F.wave * 16384);
    const int gw = F.vcu * NWAVES + F.wave, NGW = F.G * NWAVES;
    CArgs& A = *get_args(); unsigned char* const WSP = A.ws;
    constexpr int I_FF1 = 16 * 176, I_FF2 = 44 * 32, I_INM = 16 * 136, I_GT = 16 * 96, I_BO = 8 * 32, I_OO = 16 * 32;
    constexpr int NITEMS = 2 * I_FF1 + 2 * I_FF2 + I_INM + I_GT + 3 * I_BO + I_OO;
    for (int it = gw; it < NITEMS; it += NGW) {
        int r = it;
        if (r < 2 * I_FF1) {
            const int f = r / I_FF1; r -= f * I_FF1; const int kb = r / 176, nb = r % 176, t = nb >> 3, q = nb & 7;
            const int sc = (q < 4) ? (128 * t + 32 * q) : (FFN + 128 * t + 32 * (q - 4));
            transpose_item(A.in[I_WFFIN] + (size_t)(l * 2 + f) * DM * NFF1, DM, NFF1, sc, (bf16*)(WSP + WS_WFF1) + (size_t)f * NFF1 * DM, 32 * nb, 64 * kb, scr, F.lane); continue; }
        r -= 2 * I_FF1;
        if (r < 2 * I_FF2) { const int f = r / I_FF2; r -= f * I_FF2; const int kb = r / 32, nb = r % 32;
            transpose_item(A.in[I_WFFOUT] + (size_t)(l * 2 + f) * FFN * DM, FFN, DM, 32 * nb, (bf16*)(WSP + WS_WFF2) + (size_t)f * DM * FFN, 32 * nb, 64 * kb, scr, F.lane); continue; }
        r -= 2 * I_FF2;
        if (r < I_INM) { const int kb = r / 136, nb = r % 136, t = nb >> 3, q = nb & 7;
            int sc; if (t < 13) sc = 32 * nb; else { const int i = t - 13; sc = (q < 4) ? (3328 + 128 * i + 32 * q) : (3840 + 128 * i + 32 * (q - 4)); }
            transpose_item(A.in[I_WIN] + (size_t)l * DM * NIN_SRC, DM, NIN_SRC, sc, (bf16*)(WSP + WS_WINM), 32 * nb, 64 * kb, scr, F.lane); continue; }
        r -= I_INM;
        if (r < I_GT) { const int kb = r / 96, nb = r % 96;
            transpose_item(A.in[I_WIN] + (size_t)l * DM * NIN_SRC, DM, NIN_SRC, NINM + 32 * nb, (bf16*)(WSP + WS_WG), 32 * nb, 64 * kb, scr, F.lane); continue; }
        r -= I_GT;
        if (r < 3 * I_BO) { const int b = r / I_BO; r -= b * I_BO; const int kb = r / 32, nb = r % 32;
            const float* src = (b == 0 ? A.in[I_WRO] : (b == 1 ? A.in[I_WAO] : A.in[I_WCO])) + (size_t)l * 512 * DM;
            transpose_item(src, 512, DM, 32 * nb, (bf16*)(WSP + WS_WRO) + (size_t)b * DM * 512, 32 * nb, 64 * kb, scr, F.lane); continue; }
        r -= 3 * I_BO;
        { const int kb = r / 32, nb = r % 32;
          transpose_item(A.in[I_WO] + (size_t)l * DM * DM, DM, DM, 32 * nb, (bf16*)(WSP + WS_WO), 32 * nb, 64 * kb, scr, F.lane); }
    }
}
__device__ __forceinline__ void compute_mod(Frame& F) {
    CArgs& A = *get_args(); unsigned char* const WSP = A.ws;
    LAS float* sc = (LAS float*)(F.lds);
    LAS float* red = sc + 3072;
    for (int i = F.tid; i < 3072; i += 512) { const int ci = i >> 10, k = i & 1023; const float c = (ci == 0) ? A.in[I_CCTX][k] : A.in[I_C][(ci - 1) * 1024 + k]; sc[i] = c * __builtin_amdgcn_rcpf(1.0f + fexp(-c)); }
    __syncthreads();
    float* mod = (float*)(WSP + WS_MOD);
    for (int item = F.bx; item < 288; item += F.G) {
        const int l = item / 144, n0 = (item % 144) * 64, col = F.tid & 63, kg = F.tid >> 6;
        const float* w = A.in[I_WADA] + (size_t)l * DM * 9216 + n0 + col;
        float a0 = 0.f, a1 = 0.f, a2 = 0.f;
#pragma unroll 8
        for (int kk = 0; kk < 128; ++kk) { const int k = kg * 128 + kk; const float wv = w[(size_t)k * 9216]; a0 += sc[k] * wv; a1 += sc[1024 + k] * wv; a2 += sc[2048 + k] * wv; }
        red[(kg * 3 + 0) * 64 + col] = a0; red[(kg * 3 + 1) * 64 + col] = a1; red[(kg * 3 + 2) * 64 + col] = a2;
        __syncthreads();
        if (F.tid < 192) { const int ci = F.tid >> 6, c = F.tid & 63; float s = A.in[I_BADA][l * 9216 + n0 + c];
#pragma unroll
            for (int g = 0; g < 8; ++g) s += red[(g * 3 + ci) * 64 + c];
            mod[(size_t)(ci * 2 + l) * 9216 + n0 + c] = s; }
        __syncthreads();
    }
}
__device__ __forceinline__ void prologue_misc(Frame& F) {
    CArgs& A = *get_args(); unsigned char* const WSP = A.ws;
    if (F.bx == F.G - 1) {
        float* ct = (float*)(WSP + WS_ROPE); float* st = ct + 1024;
        for (int i = F.tid; i < 1024; i += 512) { const int pos = i >> 4, fi = i & 15; const float inv = fexp2(-(float)fi * 0.8304820237218406f);
            const float rev = (float)pos * inv * 0.15915494309189535f; ct[i] = __builtin_amdgcn_cosf(rev); st[i] = __builtin_amdgcn_sinf(rev); }
    }
    const int gt = F.bx * 512 + F.tid, NT = F.G * 512;
    bf16* KL = (bf16*)(WSP + WS_KL); bf16* VL = (bf16*)(WSP + WS_VL);
    for (int i = gt; i < 2 * 2 * PAST * 128; i += NT) {
        const int d = i & 63, kv = (i >> 6) & 1, s = (i >> 7) & 511, l = (i >> 16) & 1, b = i >> 17;
        const size_t dst = ((size_t)((l * 2 + b) * 2 + kv) * SKL + s) * 64 + d;
        KL[dst] = (bf16)f2bf(A.in[I_CK][i]); VL[dst] = (bf16)f2bf(A.in[I_CV][i]);
    }
}
__device__ __forceinline__ void modnorm_rows(Frame& F, int l, int j, bool from_x) {
    CArgs& A = *get_args(); unsigned char* const WSP = A.ws;
    const int gw = F.vcu * NWAVES + F.wave, NGW = F.G * NWAVES;
    const float* mod = (const float*)(WSP + WS_MOD);
    bf16* XN = (bf16*)(WSP + WS_XN);
    const float* nw = A.in[I_NORMW] + (size_t)(l * 3 + j) * DM;
    for (int m = gw; m < MTOK; m += NGW) {
        const float* xrow = from_x ? (m < MCTX ? A.in[I_XP] + (size_t)m * DM : A.in[I_XS] + (size_t)(m - MCTX) * DM) : A.out + (size_t)m * DM;
        const int ci = cond_of_row(m);
        const float* sh = mod + (size_t)(ci * 2 + l) * 9216 + (3 * j) * 1024; const float* scl = sh + 1024;
        const f32x4* xr = (const f32x4*)xrow + F.lane;
        f32x4 v[4]; float s2 = 0.f;
#pragma unroll
        for (int q = 0; q < 4; ++q) { v[q] = xr[64 * q]; s2 += (v[q].x * v[q].x + v[q].y * v[q].y) + (v[q].z * v[q].z + v[q].w * v[q].w); }
        const float rstd = frsq(wave_sum(s2) * (1.0f / DM) + EPS);
        unsigned long long* o8 = (unsigned long long*)(XN + (size_t)m * DM) + F.lane;
#pragma unroll
        for (int q = 0; q < 4; ++q) {
            const f32x4 g = ((const f32x4*)nw)[F.lane + 64 * q], s = ((const f32x4*)scl)[F.lane + 64 * q], b = ((const f32x4*)sh)[F.lane + 64 * q];
            const f32x4 y = v[q] * rstd * g * (s + 1.0f) + b;
            o8[64 * q] = (unsigned long long)pk2(y.x, y.y) | ((unsigned long long)pk2(y.z, y.w) << 32);
        }
    }
}
__device__ __forceinline__ void qk_pass(Frame& F, int l) {
    CArgs& A = *get_args(); unsigned char* const WSP = A.ws;
    const int gw = F.vcu * NWAVES + F.wave, NGW = F.G * NWAVES, lane = F.lane;
    bf16* U = (bf16*)(WSP + WS_R1);
    const float* ct = (const float*)(WSP + WS_ROPE); const float* st = ct + 1024;
    const float* qg = A.in[I_QG] + l * 64; const float* kg = A.in[I_KG] + l * 64;
    const int d0 = (lane & 7) * 8;
    const float QS = 0.125f * 1.4426950408889634f;
    for (int m = gw; m < MTOK; m += NGW) {
        const bool lat = m >= MCTX; int trow = 0, tcol = 0;
        if (lat) { const int t = (m - MCTX) & (SEQL - 1); trow = t >> 6; tcol = t & 63; }
        float cs[8], sn[8];
#pragma unroll
        for (int e = 0; e < 8; ++e) { const int i = (d0 & 31) + e; const int idx = (i < 16) ? (trow * 16 + i) : (tcol * 16 + (i - 16)); cs[e] = ct[idx]; sn[e] = st[idx]; }
        {
            bf16* qp = U + U_AQ + (size_t)m * 512 + lane * 8;
            const v4u w = *(const v4u*)qp;
            float x[8] = {blo(w.x), bhi(w.x), blo(w.y), bhi(w.y), blo(w.z), bhi(w.z), blo(w.w), bhi(w.w)};
            float ss = 0.f;
#pragma unroll
            for (int e = 0; e < 8; ++e) ss += x[e] * x[e];
            ss += __shfl_xor(ss, 1); ss += __shfl_xor(ss, 2); ss += __shfl_xor(ss, 4);
            const float r = frsq(ss * (1.0f / 64.0f) + EPS);
#pragma unroll
            for (int e = 0; e < 8; ++e) x[e] = x[e] * r * qg[d0 + e];
            if (lat) {
#pragma unroll
                for (int e = 0; e < 8; ++e) { const float p = __shfl_xor(x[e], 4); x[e] = (d0 < 32) ? (x[e] * cs[e] - p * sn[e]) : (p * sn[e] + x[e] * cs[e]); }
            }
            v4u o; o.x = pk2(x[0] * QS, x[1] * QS); o.y = pk2(x[2] * QS, x[3] * QS); o.z = pk2(x[4] * QS, x[5] * QS); o.w = pk2(x[6] * QS, x[7] * QS);
            *(v4u*)qp = o;
        }
        {
            const int l2 = lane & 31;
            const v4u w = *(const v4u*)(U + U_AKV + (size_t)m * 256 + l2 * 8);
            float x[8] = {blo(w.x), bhi(w.x), blo(w.y), bhi(w.y), blo(w.z), bhi(w.z), blo(w.w), bhi(w.w)};
            const bool isk = l2 < 16;
            float ss = 0.f;
#pragma unroll
            for (int e = 0; e < 8; ++e) ss += x[e] * x[e];
            ss += __shfl_xor(ss, 1); ss += __shfl_xor(ss, 2); ss += __shfl_xor(ss, 4);
            const float r = frsq(ss * (1.0f / 64.0f) + EPS);
            if (isk) {
#pragma unroll
                for (int e = 0; e < 8; ++e) x[e] = x[e] * r * kg[d0 + e];
            }
            const int kv = (l2 >> 3) & 1;
            if (!lat) {
                const int b = m >> 8, t = m & 255;
                if (lane < 32) {
                    float* dst = A.out + (isk ? OUT_CK : OUT_CV) + ((size_t)((b * 2 + l) * 256 + t) * 2 + kv) * 64 + d0;
                    *(f32x4*)dst = (f32x4){x[0], x[1], x[2], x[3]}; *(f32x4*)(dst + 4) = (f32x4){x[4], x[5], x[6], x[7]};
                    bf16* kc = (bf16*)(WSP + (isk ? WS_KC : WS_VC)) + ((size_t)(b * 2 + kv) * 256 + t) * 64 + d0;
                    v4u o; o.x = pk2(x[0], x[1]); o.y = pk2(x[2], x[3]); o.z = pk2(x[4], x[5]); o.w = pk2(x[6], x[7]);
                    *(v4u*)kc = o;
                }
            } else {
                float y[8];
#pragma unroll
                for (int e = 0; e < 8; ++e) { const float p = __shfl_xor(x[e], 4); y[e] = (d0 < 32) ? (x[e] * cs[e] - p * sn[e]) : (p * sn[e] + x[e] * cs[e]); }
                if (lane < 32) {
                    const int b = (m - MCTX) >> 12, t = (m - MCTX) & (SEQL - 1);
                    bf16* kc = (bf16*)(WSP + (isk ? WS_KL : WS_VL)) + ((size_t)((l * 2 + b) * 2 + kv) * SKL + PAST + t) * 64 + d0;
                    v4u o;
                    if (isk) { o.x = pk2(y[0], y[1]); o.y = pk2(y[2], y[3]); o.z = pk2(y[4], y[5]); o.w = pk2(y[6], y[7]); }
                    else { o.x = pk2(x[0], x[1]); o.y = pk2(x[2], x[3]); o.z = pk2(x[4], x[5]); o.w = pk2(x[6], x[7]); }
                    *(v4u*)kc = o;
                }
            }
        }
    }
}
__device__ __forceinline__ void conv_pass(Frame& F, int l) {
    CArgs& A = *get_args(); unsigned char* const WSP = A.ws;
    const int gw = F.vcu * NWAVES + F.wave, NGW = F.G * NWAVES, lane = F.lane;
    bf16* U = (bf16*)(WSP + WS_R1);
    const float* cw = A.in[I_CONVW] + (size_t)l * 3 * 512 + lane * 8;
    float w0[8], w1[8], w2[8];
#pragma unroll
    for (int e = 0; e < 8; ++e) { w0[e] = cw[e]; w1[e] = cw[512 + e]; w2[e] = cw[1024 + e]; }
    for (int m = gw; m < MTOK; m += NGW) {
        const int t = (m < MCTX) ? (m & 255) : ((m - MCTX) & (SEQL - 1)); const int T = (m < MCTX) ? SEQC : SEQL;
        const bf16* pp = U + U_P + (size_t)m * 512 + lane * 8;
        const v4u z = (v4u){0u, 0u, 0u, 0u};
        const v4u pc = *(const v4u*)pp, pm = (t > 0) ? *(const v4u*)(pp - 512) : z, pn = (t < T - 1) ? *(const v4u*)(pp + 512) : z;
        bf16* cbp = U + U_CB + (size_t)m * 512 + lane * 8;
        const v4u cb = *(const v4u*)cbp;
        float r[8];
        const unsigned pcw[4] = {pc.x, pc.y, pc.z, pc.w}, pmw[4] = {pm.x, pm.y, pm.z, pm.w}, pnw[4] = {pn.x, pn.y, pn.z, pn.w}, cbw[4] = {cb.x, cb.y, cb.z, cb.w};
#pragma unroll
        for (int q = 0; q < 4; ++q) {
            r[2 * q] = blo(cbw[q]) * (w0[2 * q] * blo(pmw[q]) + w1[2 * q] * blo(pcw[q]) + w2[2 * q] * blo(pnw[q]));
            r[2 * q + 1] = bhi(cbw[q]) * (w0[2 * q + 1] * bhi(pmw[q]) + w1[2 * q + 1] * bhi(pcw[q]) + w2[2 * q + 1] * bhi(pnw[q]));
        }
        v4u o; o.x = pk2(r[0], r[1]); o.y = pk2(r[2], r[3]); o.z = pk2(r[4], r[5]); o.w = pk2(r[6], r[7]);
        *(v4u*)cbp = o;
    }
}
__device__ __forceinline__ float log_gamma_of(CArgs& A, int l, int dir, int h) {
    const float x = A.in[I_DECAY][(l * 2 + dir) * 4 + h]; const float e = fexp(-x);
    const float ser = e * (1.0f - e * (0.5f - e * (0.33333334f - e * (0.25f - e * 0.2f))));
    const float big = __builtin_amdgcn_logf(1.0f + e) * 0.6931471805599453f;
    return -((e < 0.0625f) ? ser : big);
}
constexpr float RET_SCALE = 0.08838834764831845f;
__device__ __forceinline__ void ret_pass1(Frame& F, int l) {
    CArgs& A = *get_args(); unsigned char* const WSP = A.ws; const int tid = F.tid;
    bf16* U = (bf16*)(WSP + WS_R1);
    LAS bf16* Ks = (LAS bf16*)F.lds; LAS bf16* Vs = Ks + 128 * 128;
    float* LB = (float*)(WSP + WS_T);
    for (int unit = F.vcu; unit < 512; unit += F.G) {
        const int chunk = unit >> 2, h = unit & 3, m0 = chunk * 128;
        __syncthreads();
        for (int i = tid; i < 2048; i += 512) { const int j = i >> 4, c8 = (i & 15) * 8;
            *(LAS v4u*)(Ks + j * 128 + c8) = *(const v4u*)(U + U_RK + (size_t)(m0 + j) * 512 + h * 128 + c8);
            *(LAS v4u*)(Vs + j * 128 + c8) = *(const v4u*)(U + U_RV + (size_t)(m0 + j) * 512 + h * 128 + c8); }
        __syncthreads();
        const float lgf = log_gamma_of(A, l, 0, h), lgb = log_gamma_of(A, l, 1, h);
        const int d = tid >> 2, e0 = (tid & 3) * 32;
        float af[32], ab[32];
#pragma unroll
        for (int e = 0; e < 32; ++e) { af[e] = 0.f; ab[e] = 0.f; }
        for (int j = 0; j < 128; ++j) {
            const float kd = bf2f(Ks[j * 128 + d]) * RET_SCALE;
            const float kf = kd * fexp(lgf * (float)(127 - j)), kb = kd * fexp(lgb * (float)j);
#pragma unroll
            for (int q = 0; q < 4; ++q) { const v4u vv = *(const LAS v4u*)(Vs + j * 128 + e0 + q * 8);
                const float v8[8] = {blo(vv.x), bhi(vv.x), blo(vv.y), bhi(vv.y), blo(vv.z), bhi(vv.z), blo(vv.w), bhi(vv.w)};
#pragma unroll
                for (int e = 0; e < 8; ++e) { af[q * 8 + e] += kf * v8[e]; ab[q * 8 + e] += kb * v8[e]; } }
        }
        float* of = LB + ((size_t)(unit * 2 + 0) * 16384) + d * 128 + e0; float* ob = LB + ((size_t)(unit * 2 + 1) * 16384) + d * 128 + e0;
#pragma unroll
        for (int q = 0; q < 8; ++q) { *(f32x4*)(of + 4 * q) = (f32x4){af[4 * q], af[4 * q + 1], af[4 * q + 2], af[4 * q + 3]}; *(f32x4*)(ob + 4 * q) = (f32x4){ab[4 * q], ab[4 * q + 1], ab[4 * q + 2], ab[4 * q + 3]}; }
    }
}
__device__ __forceinline__ void ret_scan(Frame& F, int l) {
    CArgs& A = *get_args(); unsigned char* const WSP = A.ws;
    const float* LB = (const float*)(WSP + WS_T); float* SB = (float*)(WSP + WS_GS);
    const int gt = F.bx * 512 + F.tid, NT = F.G * 512;
    for (int i = gt; i < 65536; i += NT) {
        const int e4 = i & 4095, dir = (i >> 12) & 1, h = (i >> 13) & 3, b = i >> 15;
        const float g128 = fexp(128.0f * log_gamma_of(A, l, dir, h));
        f32x4 S = *(const f32x4*)(A.in[I_STATE] + ((size_t)(((b * 2 + l) * 2 + dir) * 4 + h) * 16384) + e4 * 4);
        for (int cc = 0; cc < 32; ++cc) {
            const int c = dir == 0 ? cc : 31 - cc; const int lc = b * 32 + c, chunk = 64 + lc;
            *(f32x4*)(SB + ((size_t)((lc * 4 + h) * 2 + dir) * 16384) + e4 * 4) = S;
            const f32x4 Lc = *(const f32x4*)(LB + ((size_t)((chunk * 4 + h) * 2 + dir) * 16384) + e4 * 4);
            S = S * g128 + Lc;
        }
    }
    for (int i = gt; i < 32 * 2 * 4 * 4096; i += NT) {
        const int e4 = i & 4095, h = (i >> 12) & 3, dir = (i >> 14) & 1, b = i >> 15;
        const float g128 = fexp(128.0f * log_gamma_of(A, l, dir, h));
        const int c_first = dir == 0 ? 0 : 1, c_second = 1 - c_first;
        const f32x4 L1 = *(const f32x4*)(LB + ((size_t)(((b * 2 + c_first) * 4 + h) * 2 + dir) * 16384) + e4 * 4);
        const f32x4 L2 = *(const f32x4*)(LB + ((size_t)(((b * 2 + c_second) * 4 + h) * 2 + dir) * 16384) + e4 * 4);
        *(f32x4*)(A.out + OUT_STATE + ((size_t)(((b * 2 + l) * 2 + dir) * 4 + h) * 16384) + e4 * 4) = L1 * g128 + L2;
    }
}
__device__ __forceinline__ void ret_pass3(Frame& F, int l) {
    CArgs& A = *get_args(); unsigned char* const WSP = A.ws; const int tid = F.tid;
    bf16* U = (bf16*)(WSP + WS_R1);
    LAS bf16* Qs = (LAS bf16*)F.lds; LAS bf16* KVs = Qs + 128 * 128; LAS float* As = (LAS float*)(F.lds + 65536);
    const float* LB = (const float*)(WSP + WS_T); const float* SB = (const float*)(WSP + WS_GS);
    for (int unit = F.vcu; unit < 512; unit += F.G) {
        const int chunk = unit >> 2, h = unit & 3, m0 = chunk * 128;
        __syncthreads();
        for (int i = tid; i < 2048; i += 512) { const int j = i >> 4, c8 = (i & 15) * 8;
            *(LAS v4u*)(Qs + j * 128 + c8) = *(const v4u*)(U + U_RQ + (size_t)(m0 + j) * 512 + h * 128 + c8);
            *(LAS v4u*)(KVs + j * 128 + c8) = *(const v4u*)(U + U_RK + (size_t)(m0 + j) * 512 + h * 128 + c8); }
        __syncthreads();
        const float lgf = log_gamma_of(A, l, 0, h), lgb = log_gamma_of(A, l, 1, h);
        const int i = tid >> 2, jq = tid & 3;
        {
            float acc[32];
#pragma unroll
            for (int jj = 0; jj < 32; ++jj) acc[jj] = 0.f;
            for (int db = 0; db < 16; ++db) {
                const v4u qw = *(const LAS v4u*)(Qs + i * 128 + db * 8);
                const float q8[8] = {blo(qw.x), bhi(qw.x), blo(qw.y), bhi(qw.y), blo(qw.z), bhi(qw.z), blo(qw.w), bhi(qw.w)};
#pragma unroll
                for (int jj = 0; jj < 32; ++jj) { const v4u kw = *(const LAS v4u*)(KVs + (jq + 4 * jj) * 128 + db * 8);
                    acc[jj] += q8[0] * blo(kw.x) + q8[1] * bhi(kw.x) + q8[2] * blo(kw.y) + q8[3] * bhi(kw.y) + q8[4] * blo(kw.z) + q8[5] * bhi(kw.z) + q8[6] * blo(kw.w) + q8[7] * bhi(kw.w); }
            }
#pragma unroll
            for (int jj = 0; jj < 32; ++jj) { const int j = jq + 4 * jj;
                const float dm = (i > j) ? fexp(lgf * (float)(i - j)) : ((j > i) ? fexp(lgb * (float)(j - i)) : 2.0f);
                As[i * 128 + j] = acc[jj] * dm * RET_SCALE; }
        }
        __syncthreads();
        for (int ii = tid; ii < 2048; ii += 512) { const int j = ii >> 4, c8 = (ii & 15) * 8;
            *(LAS v4u*)(KVs + j * 128 + c8) = *(const v4u*)(U + U_RV + (size_t)(m0 + j) * 512 + h * 128 + c8); }
        __syncthreads();
        const int e0 = jq * 32;
        float o[32];
#pragma unroll
        for (int e = 0; e < 32; ++e) o[e] = 0.f;
        for (int j = 0; j < 128; ++j) { const float a = As[i * 128 + j];
#pragma unroll
            for (int q = 0; q < 4; ++q) { const v4u vv = *(const LAS v4u*)(KVs + j * 128 + e0 + q * 8);
                o[q * 8 + 0] += a * blo(vv.x); o[q * 8 + 1] += a * bhi(vv.x); o[q * 8 + 2] += a * blo(vv.y); o[q * 8 + 3] += a * bhi(vv.y);
                o[q * 8 + 4] += a * blo(vv.z); o[q * 8 + 5] += a * bhi(vv.z); o[q * 8 + 6] += a * blo(vv.w); o[q * 8 + 7] += a * bhi(vv.w); } }
        const float* Sf = nullptr; const float* Sb = nullptr;
        if (chunk < 64) { const int b = chunk >> 1, c = chunk & 1;
            if (c == 1) Sf = LB + ((size_t)((((b * 2 + 0) * 4 + h) * 2 + 0)) * 16384); else Sb = LB + ((size_t)((((b * 2 + 1) * 4 + h) * 2 + 1)) * 16384);
        } else { const int lc = chunk - 64; Sf = SB + ((size_t)((lc * 4 + h) * 2 + 0) * 16384); Sb = SB + ((size_t)((lc * 4 + h) * 2 + 1) * 16384); }
        const float dqf = fexp(lgf * (float)(i + 1)), dqb = fexp(lgb * (float)(128 - i));
        if (Sf) { for (int d = 0; d < 128; ++d) { const float qd = bf2f(Qs[i * 128 + d]) * dqf; const float* sp = Sf + d * 128 + e0;
#pragma unroll
                for (int q = 0; q < 8; ++q) { const f32x4 s = *(const f32x4*)(sp + 4 * q); o[4 * q] += qd * s.x; o[4 * q + 1] += qd * s.y; o[4 * q + 2] += qd * s.z; o[4 * q + 3] += qd * s.w; } } }
        if (Sb) { for (int d = 0; d < 128; ++d) { const float qd = bf2f(Qs[i * 128 + d]) * dqb; const float* sp = Sb + d * 128 + e0;
#pragma unroll
                for (int q = 0; q < 8; ++q) { const f32x4 s = *(const f32x4*)(sp + 4 * q); o[4 * q] += qd * s.x; o[4 * q + 1] += qd * s.y; o[4 * q + 2] += qd * s.z; o[4 * q + 3] += qd * s.w; } } }
        float ss = 0.f;
#pragma unroll
        for (int e = 0; e < 32; ++e) ss += o[e] * o[e];
        ss += __shfl_xor(ss, 1); ss += __shfl_xor(ss, 2);
        const float r = frsq(ss * (1.0f / 128.0f) + EPS);
        const float* gn = A.in[I_RETGN] + l * 512 + h * 128 + e0;
        const bf16* sg = U + U_SRG + (size_t)(m0 + i) * 512 + h * 128 + e0;
        bf16* op = U + U_RQ + (size_t)(m0 + i) * 512 + h * 128 + e0;
#pragma unroll
        for (int q = 0; q < 4; ++q) { const v4u g = *(const v4u*)(sg + q * 8);
            const float g8[8] = {blo(g.x), bhi(g.x), blo(g.y), bhi(g.y), blo(g.z), bhi(g.z), blo(g.w), bhi(g.w)};
            float y[8];
#pragma unroll
            for (int e = 0; e < 8; ++e) y[e] = o[q * 8 + e] * r * gn[q * 8 + e] * g8[e];
            v4u w; w.x = pk2(y[0], y[1]); w.y = pk2(y[2], y[3]); w.z = pk2(y[4], y[5]); w.w = pk2(y[6], y[7]);
            *(v4u*)(op + q * 8) = w; }
    }
}
typedef float f32x16r __attribute__((ext_vector_type(16)));
typedef short s16x8r __attribute__((ext_vector_type(8)));
typedef short s16x4r __attribute__((ext_vector_type(4)));
constexpr int RLD = 136;
constexpr int RTILE = 128 * RLD * 2;
__device__ __forceinline__ int crow32(int r, int hi) { return (r & 3) + 8 * (r >> 2) + 4 * hi; }
__device__ __forceinline__ s16x8r frag_direct(const LAS bf16* T, int row, int col) { return *(const LAS s16x8r*)(T + row * RLD + col); }
__device__ __forceinline__ s16x8r frag_tr(const LAS bf16* T, int kbase, int cbase, int lane) {
    const int h = lane >> 5, g = (lane >> 4) & 1, q = (lane & 15) >> 2, p = lane & 3;
    const LAS bf16* a = T + (kbase + 8 * h + q) * RLD + cbase + 16 * g + 4 * p;
    const s16x4r lo = __builtin_bit_cast(s16x4r, __builtin_amdgcn_ds_read_tr16_b64_v4i16((LAS s16x4r*)a));
    const s16x4r hi = __builtin_bit_cast(s16x4r, __builtin_amdgcn_ds_read_tr16_b64_v4i16((LAS s16x4r*)(a + 4 * RLD)));
    return (s16x8r){lo[0], lo[1], lo[2], lo[3], hi[0], hi[1], hi[2], hi[3]};
}
__device__ __forceinline__ void ret_pass1_mfma(Frame& F, int l) {
    CArgs& A = *get_args(); unsigned char* const WSP = A.ws; const int tid = F.tid, lane = F.lane, w = F.wave;
    const bf16* U = (const bf16*)(WSP + WS_R1);
    LAS bf16* Kf = (LAS bf16*)F.lds; LAS bf16* Kb = (LAS bf16*)(F.lds + RTILE); LAS bf16* Vs = (LAS bf16*)(F.lds + 2 * RTILE);
    float* LB = (float*)(WSP + WS_T);
    for (int unit = F.vcu; unit < 512; unit += F.G) {
        const int chunk = unit >> 2, h = unit & 3, m0 = chunk * 128;
        const float lgf = log_gamma_of(A, l, 0, h) * 1.4426950408889634f, lgb = log_gamma_of(A, l, 1, h) * 1.4426950408889634f;
        __syncthreads();
#pragma unroll
        for (int r = 0; r < 4; ++r) { const int i = tid + 512 * r, j = i >> 4, c8 = (i & 15) * 8;
            const v4u kk = *(const v4u*)(U + U_RK + (size_t)(m0 + j) * 512 + h * 128 + c8), vv = *(const v4u*)(U + U_RV + (size_t)(m0 + j) * 512 + h * 128 + c8);
            const float wf = RET_SCALE * fexp2(lgf * (float)(127 - j)), wb = RET_SCALE * fexp2(lgb * (float)j);
            v4u of, ob; of.x = pk2(blo(kk.x) * wf, bhi(kk.x) * wf); of.y = pk2(blo(kk.y) * wf, bhi(kk.y) * wf); of.z = pk2(blo(kk.z) * wf, bhi(kk.z) * wf); of.w = pk2(blo(kk.w) * wf, bhi(kk.w) * wf);
            ob.x = pk2(blo(kk.x) * wb, bhi(kk.x) * wb); ob.y = pk2(blo(kk.y) * wb, bhi(kk.y) * wb); ob.z = pk2(blo(kk.z) * wb, bhi(kk.z) * wb); ob.w = pk2(blo(kk.w) * wb, bhi(kk.w) * wb);
            *(LAS v4u*)(Kf + j * RLD + c8) = of; *(LAS v4u*)(Kb + j * RLD + c8) = ob; *(LAS v4u*)(Vs + j * RLD + c8) = vv; }
        __syncthreads();
        const int dir = w >> 2, db = w & 3; const LAS bf16* Tk = dir ? Kb : Kf;
        f32x16r acc[4];
#pragma unroll
        for (int e = 0; e < 4; ++e) acc[e] = (f32x16r){0.f, 0.f, 0.f, 0.f, 0.f, 0.f, 0.f, 0.f, 0.f, 0.f, 0.f, 0.f, 0.f, 0.f, 0.f, 0.f};
#pragma unroll 2
        for (int ks = 0; ks < 8; ++ks) {
            const s16x8r a = frag_tr(Tk, ks * 16, db * 32, lane);
#pragma unroll
            for (int e = 0; e < 4; ++e) { const s16x8r b = frag_tr(Vs, ks * 16, e * 32, lane); acc[e] = __builtin_amdgcn_mfma_f32_32x32x16_bf16(a, b, acc[e], 0, 0, 0); }
        }
        float* Lo = LB + (size_t)(unit * 2 + dir) * 16384;
#pragma unroll
        for (int e = 0; e < 4; ++e)
#pragma unroll
            for (int r = 0; r < 16; ++r) Lo[(db * 32 + crow32(r, lane >> 5)) * 128 + e * 32 + (lane & 31)] = acc[e][r];
    }
    __syncthreads();
}
__device__ __forceinline__ void ret_pass3_mfma(Frame& F, int l) {
    CArgs& A = *get_args(); unsigned char* const WSP = A.ws; const int tid = F.tid, lane = F.lane, w = F.wave;
    bf16* U = (bf16*)(WSP + WS_R1);
    LAS bf16* Qs = (LAS bf16*)F.lds; LAS bf16* Ks = (LAS bf16*)(F.lds + RTILE); LAS bf16* Vs = (LAS bf16*)(F.lds + 2 * RTILE); LAS bf16* Ps = (LAS bf16*)(F.lds + 3 * RTILE);
    LAS float* Os = (LAS float*)F.lds;
    const float* LB = (const float*)(WSP + WS_T); const float* SB = (const float*)(WSP + WS_GS);
    for (int unit = F.vcu; unit < 512; unit += F.G) {
        const int chunk = unit >> 2, h = unit & 3, m0 = chunk * 128;
        const float lgf = log_gamma_of(A, l, 0, h) * 1.4426950408889634f, lgb = log_gamma_of(A, l, 1, h) * 1.4426950408889634f;
        const float* Sf = nullptr; const float* Sb = nullptr;
        if (chunk < 64) { const int b = chunk >> 1, c = chunk & 1;
            if (c == 1) Sf = LB + ((size_t)((((b * 2 + 0) * 4 + h) * 2 + 0)) * 16384); else Sb = LB + ((size_t)((((b * 2 + 1) * 4 + h) * 2 + 1)) * 16384);
        } else { const int lc = chunk - 64; Sf = SB + ((size_t)((lc * 4 + h) * 2 + 0) * 16384); Sb = SB + ((size_t)((lc * 4 + h) * 2 + 1) * 16384); }
        __syncthreads();
#pragma unroll 1
        for (int r = 0; r < 4; ++r) { const int i = tid + 512 * r, j = i >> 4, c8 = (i & 15) * 8; const size_t g = (size_t)(m0 + j) * 512 + h * 128 + c8;
            *(LAS v4u*)(Qs + j * RLD + c8) = *(const v4u*)(U + U_RQ + g); *(LAS v4u*)(Ks + j * RLD + c8) = *(const v4u*)(U + U_RK + g); *(LAS v4u*)(Vs + j * RLD + c8) = *(const v4u*)(U + U_RV + g); }
        __syncthreads();
        const int ib = w >> 1, hi = lane >> 5, r32 = lane & 31;
        {
            f32x16r sa[2];
#pragma unroll
            for (int q = 0; q < 2; ++q) sa[q] = (f32x16r){0.f, 0.f, 0.f, 0.f, 0.f, 0.f, 0.f, 0.f, 0.f, 0.f, 0.f, 0.f, 0.f, 0.f, 0.f, 0.f};
#pragma unroll 2
            for (int ks = 0; ks < 8; ++ks) { const s16x8r a = frag_direct(Qs, ib * 32 + r32, ks * 16 + 8 * hi);
#pragma unroll
                for (int q = 0; q < 2; ++q) { const s16x8r b = frag_direct(Ks, ((w & 1) * 2 + q) * 32 + r32, ks * 16 + 8 * hi); sa[q] = __builtin_amdgcn_mfma_f32_32x32x16_bf16(a, b, sa[q], 0, 0, 0); } }
#pragma unroll
            for (int q = 0; q < 2; ++q) { const int j = ((w & 1) * 2 + q) * 32 + r32;
#pragma unroll
                for (int r = 0; r < 16; ++r) { const int i = ib * 32 + crow32(r, hi); const int d = i - j;
                    const float dm = (d > 0) ? fexp2(lgf * (float)d) : ((d < 0) ? fexp2(lgb * (float)(-d)) : 2.0f);
                    Ps[i * RLD + j] = (bf16)f2bf(sa[q][r] * dm * RET_SCALE); } }
        }
        __syncthreads();
        f32x16r ao[2], af[2], ab[2];
#pragma unroll
        for (int q = 0; q < 2; ++q) { ao[q] = (f32x16r){0.f, 0.f, 0.f, 0.f, 0.f, 0.f, 0.f, 0.f, 0.f, 0.f, 0.f, 0.f, 0.f, 0.f, 0.f, 0.f}; af[q] = ao[q]; ab[q] = ao[q]; }
        const int eb0 = (w & 1) * 2;
        if (Sf) {
#pragma unroll 2
            for (int r = 0; r < 8; ++r) { const int i = tid + 512 * r, d = i >> 5, c4 = (i & 31) * 4; const f32x4 v = *(const f32x4*)(Sf + d * 128 + c4);
                *(LAS unsigned long long*)(Ks + d * RLD + c4) = (unsigned long long)pk2(v.x, v.y) | ((unsigned long long)pk2(v.z, v.w) << 32); } }
#pragma unroll 2
        for (int ks = 0; ks < 8; ++ks) { const s16x8r a = frag_direct(Ps, ib * 32 + r32, ks * 16 + 8 * hi);
#pragma unroll
            for (int q = 0; q < 2; ++q) { const s16x8r b = frag_tr(Vs, ks * 16, (eb0 + q) * 32, lane); ao[q] = __builtin_amdgcn_mfma_f32_32x32x16_bf16(a, b, ao[q], 0, 0, 0); } }
        __syncthreads();
        if (Sf) {
#pragma unroll 2
            for (int ks = 0; ks < 8; ++ks) { const s16x8r a = frag_direct(Qs, ib * 32 + r32, ks * 16 + 8 * hi);
#pragma unroll
                for (int q = 0; q < 2; ++q) { const s16x8r b = frag_tr(Ks, ks * 16, (eb0 + q) * 32, lane); af[q] = __builtin_amdgcn_mfma_f32_32x32x16_bf16(a, b, af[q], 0, 0, 0); } } }
        __syncthreads();
        if (Sb) {
#pragma unroll 2
            for (int r = 0; r < 8; ++r) { const int i = tid + 512 * r, d = i >> 5, c4 = (i & 31) * 4; const f32x4 v = *(const f32x4*)(Sb + d * 128 + c4);
                *(LAS unsigned long long*)(Ks + d * RLD + c4) = (unsigned long long)pk2(v.x, v.y) | ((unsigned long long)pk2(v.z, v.w) << 32); }
            __syncthreads();
#pragma unroll 2
            for (int ks = 0; ks < 8; ++ks) { const s16x8r a = frag_direct(Qs, ib * 32 + r32, ks * 16 + 8 * hi);
#pragma unroll
                for (int q = 0; q < 2; ++q) { const s16x8r b = frag_tr(Ks, ks * 16, (eb0 + q) * 32, lane); ab[q] = __builtin_amdgcn_mfma_f32_32x32x16_bf16(a, b, ab[q], 0, 0, 0); } }
        }
        __syncthreads();
#pragma unroll
        for (int q = 0; q < 2; ++q)
#pragma unroll
            for (int r = 0; r < 16; ++r) { const int il = ib * 32 + crow32(r, hi);
                const float dqf = fexp2(lgf * (float)(il + 1)), dqb = fexp2(lgb * (float)(128 - il));
                Os[il * 132 + (eb0 + q) * 32 + r32] = ao[q][r] + dqf * af[q][r] + dqb * ab[q][r]; }
        __syncthreads();
        {
            const int i = tid >> 2, e0 = (tid & 3) * 32; float o[32]; float ss = 0.f;
#pragma unroll
            for (int q = 0; q < 8; ++q) { const f32x4 v = *(const LAS f32x4*)(Os + i * 132 + e0 + 4 * q); o[4 * q] = v.x; o[4 * q + 1] = v.y; o[4 * q + 2] = v.z; o[4 * q + 3] = v.w; ss += (v.x * v.x + v.y * v.y) + (v.z * v.z + v.w * v.w); }
            ss += __shfl_xor(ss, 1); ss += __shfl_xor(ss, 2);
            const float rr = frsq(ss * (1.0f / 128.0f) + EPS);
            const float* gn = A.in[I_RETGN] + l * 512 + h * 128 + e0;
            const bf16* sg = U + U_SRG + (size_t)(m0 + i) * 512 + h * 128 + e0;
            bf16* op = U + U_RQ + (size_t)(m0 + i) * 512 + h * 128 + e0;
#pragma unroll
            for (int q = 0; q < 4; ++q) { const v4u g = *(const v4u*)(sg + q * 8);
                const float g8[8] = {blo(g.x), bhi(g.x), blo(g.y), bhi(g.y), blo(g.z), bhi(g.z), blo(g.w), bhi(g.w)};
                float y[8];
#pragma unroll
                for (int e = 0; e < 8; ++e) y[e] = o[q * 8 + e] * rr * gn[q * 8 + e] * g8[e];
                v4u wv; wv.x = pk2(y[0], y[1]); wv.y = pk2(y[2], y[3]); wv.z = pk2(y[4], y[5]); wv.w = pk2(y[6], y[7]);
                *(v4u*)(op + q * 8) = wv; }
        }
    }
    __syncthreads();
}

__device__ __forceinline__ void attn_naive(Frame& F, int l) {
    CArgs& A = *get_args(); unsigned char* const WSP = A.ws;
    const int tid = F.tid;
    bf16* U = (bf16*)(WSP + WS_R1);
    LAS bf16* KT = (LAS bf16*)F.lds;
    LAS bf16* VT = KT + 64 * 64;
    const int tq = tid >> 1, dh = (tid & 1) * 32;
    for (int it = F.vcu; it < 512; it += F.G) {
        int m0, hh, S; const bf16* Kb; const bf16* Vb;
        if (it >= 256) { const int i = it - 256, b = i >> 3; hh = i & 7; m0 = b * 256; S = 256;
            Kb = (const bf16*)(WSP + WS_KC) + (size_t)(b * 2 + (hh >> 2)) * 256 * 64; Vb = (const bf16*)(WSP + WS_VC) + (size_t)(b * 2 + (hh >> 2)) * 256 * 64;
        } else { const int b = it >> 7, qb = it & 15; hh = (it >> 4) & 7; m0 = MCTX + b * SEQL + qb * 256; S = SKL;
            Kb = (const bf16*)(WSP + WS_KL) + (size_t)((l * 2 + b) * 2 + (hh >> 2)) * SKL * 64; Vb = (const bf16*)(WSP + WS_VL) + (size_t)((l * 2 + b) * 2 + (hh >> 2)) * SKL * 64; }
        bf16* qp = U + U_AQ + (size_t)(m0 + tq) * 512 + hh * 64 + dh;
        float q[32], o[32];
#pragma unroll
        for (int c = 0; c < 4; ++c) { const v4u w = *(const v4u*)(qp + c * 8);
            q[c * 8] = blo(w.x); q[c * 8 + 1] = bhi(w.x); q[c * 8 + 2] = blo(w.y); q[c * 8 + 3] = bhi(w.y); q[c * 8 + 4] = blo(w.z); q[c * 8 + 5] = bhi(w.z); q[c * 8 + 6] = blo(w.w); q[c * 8 + 7] = bhi(w.w); }
#pragma unroll
        for (int d = 0; d < 32; ++d) o[d] = 0.f;
        float mrun = -INFINITY, lrun = 0.f;
        const int ntile = S >> 6;
        for (int t = 0; t < ntile; ++t) {
            __syncthreads();
            { const int r = tid >> 3, c8 = (tid & 7) * 8; const size_t g = (size_t)(t * 64 + r) * 64 + c8;
              *(LAS v4u*)(KT + r * 64 + c8) = *(const v4u*)(Kb + g); *(LAS v4u*)(VT + r * 64 + c8) = *(const v4u*)(Vb + g); }
            __syncthreads();
#pragma unroll 1
            for (int jb = 0; jb < 64; jb += 4) {
                float s[4]; float tmax = -INFINITY;
#pragma unroll
                for (int j = 0; j < 4; ++j) { float a = 0.f;
#pragma unroll
                    for (int c = 0; c < 4; ++c) { const v4u w = *(const LAS v4u*)(KT + (jb + j) * 64 + dh + c * 8);
                        a += q[c * 8] * blo(w.x) + q[c * 8 + 1] * bhi(w.x) + q[c * 8 + 2] * blo(w.y) + q[c * 8 + 3] * bhi(w.y) + q[c * 8 + 4] * blo(w.z) + q[c * 8 + 5] * bhi(w.z) + q[c * 8 + 6] * blo(w.w) + q[c * 8 + 7] * bhi(w.w); }
                    a += __shfl_xor(a, 1);
                    s[j] = a; tmax = fmaxf(tmax, a); }
                const float mnew = fmaxf(mrun, tmax), alpha = fexp2(mrun - mnew);
                lrun *= alpha;
#pragma unroll
                for (int d = 0; d < 32; ++d) o[d] *= alpha;
#pragma unroll
                for (int j = 0; j < 4; ++j) { const float p = fexp2(s[j] - mnew); lrun += p;
#pragma unroll
                    for (int c = 0; c < 4; ++c) { const v4u w = *(const LAS v4u*)(VT + (jb + j) * 64 + dh + c * 8);
                        o[c * 8] += p * blo(w.x); o[c * 8 + 1] += p * bhi(w.x); o[c * 8 + 2] += p * blo(w.y); o[c * 8 + 3] += p * bhi(w.y); o[c * 8 + 4] += p * blo(w.z); o[c * 8 + 5] += p * bhi(w.z); o[c * 8 + 6] += p * blo(w.w); o[c * 8 + 7] += p * bhi(w.w); } }
                mrun = mnew;
            }
        }
        const float inv = 1.0f / lrun;
#pragma unroll
        for (int c = 0; c < 4; ++c) { float y[8];
#pragma unroll
            for (int e = 0; e < 8; ++e) y[e] = o[c * 8 + e] * inv;
            v4u w; w.x = pk2(y[0], y[1]); w.y = pk2(y[2], y[3]); w.z = pk2(y[4], y[5]); w.w = pk2(y[6], y[7]);
            *(v4u*)(qp + c * 8) = w; }
    }
    __syncthreads();
}


#ifndef USE_MFMA_RET
#define USE_MFMA_RET 1
#endif
#ifndef USE_MFMA_ATTN
#define USE_MFMA_ATTN 1
#endif
__device__ __forceinline__ void attn_mfma(Frame& F, int l) {
    CArgs& A = *get_args(); unsigned char* const WSP = A.ws;
    const attn_body::bf16* U = (const attn_body::bf16*)(WSP + WS_R1);
    __syncthreads();
    for (int it = F.vcu; it < 512; it += F.G) {
        int m0, hh, NT; const attn_body::bf16* Kb; const attn_body::bf16* Vb;
        if (it >= 256) { const int i = it - 256, b = i >> 3; hh = i & 7; m0 = b * 256; NT = 4;
            Kb = (const attn_body::bf16*)(WSP + WS_KC) + (size_t)(b * 2 + (hh >> 2)) * 256 * 64; Vb = (const attn_body::bf16*)(WSP + WS_VC) + (size_t)(b * 2 + (hh >> 2)) * 256 * 64;
        } else { const int b = it >> 7, qb = it & 15; hh = (it >> 4) & 7; m0 = MCTX + b * SEQL + qb * 256; NT = SKL / 64;
            Kb = (const attn_body::bf16*)(WSP + WS_KL) + (size_t)((l * 2 + b) * 2 + (hh >> 2)) * SKL * 64; Vb = (const attn_body::bf16*)(WSP + WS_VL) + (size_t)((l * 2 + b) * 2 + (hh >> 2)) * SKL * 64; }
        attn_body::bf16* qo = (attn_body::bf16*)(U + U_AQ + (size_t)m0 * 512 + hh * 64);
        attn_body::attn_unit<8>(qo, Kb, Vb, qo, NT, (char*)F.lds, F.tid);
    }
    asm volatile("s_waitcnt vmcnt(0) lgkmcnt(0)" ::: "memory"); __syncthreads();
}

#ifndef DBG
#define DBG 0
#endif
#if DBG
constexpr int CW_DBG = 2048;
__device__ __forceinline__ void dbg_report(unsigned* ctl, int check, float got, float ref, int lane) {
    const float err = fabsf(got - ref), tol = 0.05f * fabsf(ref) + 0.05f;
    const float rel = err / (fabsf(ref) + 0.5f);
    if (!(err <= tol)) atomicOr(ctl + CW_DBG, 1u << check);
    atomicMax(ctl + CW_DBG + 1 + check, __float_as_uint(rel == rel ? rel : 1e30f));
    atomicAdd((float*)(ctl + CW_DBG + 64 + 2 * check), err * err); atomicAdd((float*)(ctl + CW_DBG + 65 + 2 * check), ref * ref);
}
__device__ __forceinline__ float dbg_dot(const bf16* arow, const float* W, int K, int srcN, int col, int lane) {
    float a = 0.f; for (int k = lane; k < K; k += 64) a += bf2f(arow[k]) * W[(size_t)k * srcN + col]; return wave_sum(a);
}
__device__ __forceinline__ float dbg_sig(float x) { return 1.0f / (1.0f + __expf(-x)); }
__device__ __forceinline__ float dbg_qk_dim(CArgs& A, unsigned char* ws, int l, int m, int slot, int lane) {
    const bf16* xn = (const bf16*)(ws + WS_XN) + (size_t)m * DM;
    const float* W = A.in[I_WIN] + (size_t)l * DM * NIN_SRC;
    const int col0 = slot < 8 ? 2048 + slot * 64 : 2560 + (slot - 8) * 64;
    float mine = 0.f;
    for (int d = 0; d < 64; ++d) { const float v = dbg_dot(xn, W, DM, NIN_SRC, col0 + d, lane); if (d == lane) mine = v; }
    mine = bf2f((unsigned short)f2bf(mine));
    const float ss = wave_sum(mine * mine);
    const float g = slot < 8 ? A.in[I_QG][l * 64 + lane] : A.in[I_KG][l * 64 + lane];
    float y = mine * (1.0f / sqrtf(ss / 64.0f + EPS)) * g;
    if (m >= MCTX) {
        const int t = (m - MCTX) % SEQL, row = t / 64, colp = t % 64, i = lane & 31;
        const float pos = (i < 16) ? (float)row : (float)colp; const int fi = i & 15;
        const float inv = __powf(10000.0f, -(float)fi / 16.0f); const float ang = pos * inv;
        const float c = __cosf(ang), sn = __sinf(ang);
        const float other = __shfl_xor(y, 32);
        y = (lane < 32) ? (y * c - other * sn) : (other * sn + y * c);
    }
    return y;
}
__device__ __forceinline__ void dbg_checks(Frame& F, int check) {
    CArgs& A = *get_args(); unsigned char* const ws = A.ws; unsigned* ctl = (unsigned*)(ws + WS_CTL);
    const int gw = F.bx * NWAVES + F.wave, lane = F.lane;
    const float* mod = (const float*)(ws + WS_MOD);
    const bf16* XN = (const bf16*)(ws + WS_XN); const bf16* U = (const bf16*)(ws + WS_R1);
    if (check == 40) {
        const bf16* WG = (const bf16*)(ws + WS_WG); const bf16* GSb = (const bf16*)(ws + WS_GS);
        for (size_t o = (size_t)F.bx * 512 + F.tid; o < (size_t)MTOK * DM; o += (size_t)F.G * 512) {
            const int mm = (int)(o >> 10), n = (int)(o & 1023); const v4u* xr = (const v4u*)(XN + (size_t)mm * DM); const v4u* wr_ = (const v4u*)(WG + (size_t)n * DM);
            float acc = 0.f;
            for (int k8 = 0; k8 < 128; ++k8) { const v4u a = xr[k8], b = wr_[k8];
                acc += blo(a.x) * blo(b.x) + bhi(a.x) * bhi(b.x) + blo(a.y) * blo(b.y) + bhi(a.y) * bhi(b.y) + blo(a.z) * blo(b.z) + bhi(a.z) * bhi(b.z) + blo(a.w) * blo(b.w) + bhi(a.w) * bhi(b.w); }
            const float ref = dbg_sig(acc), got = bf2f(GSb[o]);
            if ((mm & 255) >= 128 && (mm & 63) >= 48 && (n & 128)) { const float raw = ((const float*)(ws + WS_T))[o]; if (!(fabsf(raw - acc) <= 0.02f + 0.01f * fabsf(acc))) atomicAdd(ctl + CW_DBG + 210, 1u); else atomicAdd(ctl + CW_DBG + 211, 1u); }
            if (!(fabsf(got - ref) <= 0.02f)) { atomicAdd(ctl + CW_DBG + 200, 1u); atomicAdd(ctl + CW_DBG + 256 + (mm >> 8), 1u); atomicAdd(ctl + CW_DBG + 384 + (mm & 255), 1u); atomicAdd(ctl + CW_DBG + 201 + ((n >> 7) & 1), 1u); }
        }
        return; }
    if (check == 41) {
        const bf16* WI = (const bf16*)(ws + WS_WINM) + (size_t)1536 * DM; const bf16* SR = U + U_SRG;
        for (size_t o = (size_t)F.bx * 512 + F.tid; o < (size_t)MTOK * 512; o += (size_t)F.G * 512) {
            const int mm = (int)(o >> 9), n = (int)(o & 511); const v4u* xr = (const v4u*)(XN + (size_t)mm * DM); const v4u* wr_ = (const v4u*)(WI + (size_t)n * DM);
            float acc = 0.f;
            for (int k8 = 0; k8 < 128; ++k8) { const v4u a = xr[k8], b = wr_[k8];
                acc += blo(a.x) * blo(b.x) + bhi(a.x) * bhi(b.x) + blo(a.y) * blo(b.y) + bhi(a.y) * bhi(b.y) + blo(a.z) * blo(b.z) + bhi(a.z) * bhi(b.z) + blo(a.w) * blo(b.w) + bhi(a.w) * bhi(b.w); }
            const float ref = acc * dbg_sig(acc), got = bf2f(SR[o]);
            if (!(fabsf(got - ref) <= 0.02f + 0.02f * fabsf(ref))) { atomicAdd(ctl + CW_DBG + 200, 1u); atomicAdd(ctl + CW_DBG + 256 + (mm >> 8), 1u); atomicAdd(ctl + CW_DBG + 384 + (mm & 255), 1u); atomicAdd(ctl + CW_DBG + 201 + ((n >> 7) & 1), 1u); }
        }
        return; }
    if (check == 30 || check == 31) {
        const unsigned* X = (const unsigned*)XN; unsigned acc = 0, accf = 0;
        for (size_t i = (size_t)F.bx * 512 + F.tid; i < (size_t)MTOK * DM / 2; i += (size_t)F.G * 512) { const unsigned w = X[i]; acc += w * 2654435761u + (unsigned)i; const size_t row = i / 512; if (row >= 10168 && row < 10176) accf += w * 2654435761u + (unsigned)i; }
        atomicAdd(ctl + CW_DBG + 100 + (check - 30), acc); atomicAdd(ctl + CW_DBG + 102 + (check - 30), accf);
        return; }
    if (check >= 20 && check < 26) {
        const int step = check - 20, b = step >> 1; const float* W = A.in[I_WIN];
        for (int rep = 0; rep < 4; ++rep) { const int m = 10168 + (gw & 7); const int n = ((gw >> 3) + 256 * rep) % DM;
            float tsum = 0.f, gl = 0.f;
            for (int bb = 0; bb <= b; ++bb) { const float g = dbg_sig(dbg_dot(XN + (size_t)m * DM, W, DM, NIN_SRC, NINM + 1024 * bb + n, lane)); gl = g;
                if (bb < b || (step & 1)) { const bf16* Ab = U + (bb == 0 ? U_RQ : (bb == 1 ? U_AQ : U_CB)) + (size_t)m * 512;
                    const float* Wo = (bb == 0 ? A.in[I_WRO] : (bb == 1 ? A.in[I_WAO] : A.in[I_WCO])); tsum += g * dbg_dot(Ab, Wo, 512, DM, n, lane); } }
            if (step == 0) { float mx = 0.f; for (int k = lane; k < DM; k += 64) mx = fmaxf(mx, fabsf(bf2f(XN[(size_t)m * DM + k])));
                for (int o = 1; o < 64; o <<= 1) mx = fmaxf(mx, __shfl_xor(mx, o));
                float a2 = 0.f; for (int k = lane; k < DM; k += 64) a2 += bf2f(XN[(size_t)m * DM + k]) * bf2f((unsigned short)f2bf(W[(size_t)k * NIN_SRC + NINM + n])); a2 = dbg_sig(wave_sum(a2));
                float rn = 0.f; for (int k = lane; k < DM; k += 64) { const float x = bf2f(XN[(size_t)m * DM + k]); rn += x * x; } rn = sqrtf(wave_sum(rn));
                if (lane == 0) { atomicMax(ctl + CW_DBG + 61, __float_as_uint(rn)); const float gsv = bf2f(((const bf16*)(ws + WS_GS))[(size_t)m * DM + n]); if (!(fabsf(gsv - gl) <= 0.05f * gl + 0.05f)) atomicAdd(ctl + CW_DBG + 60, 1u);
                    if (!(fabsf(gsv - a2) <= 0.05f * a2 + 0.05f)) { atomicAdd(ctl + CW_DBG + 62, 1u); atomicOr(ctl + CW_DBG + 110, 1u << (n >> 7)); atomicOr(ctl + CW_DBG + 111, 1u << ((n >> 3) & 15)); atomicOr(ctl + CW_DBG + 112, 1u << (n & 7)); } } }
            if (lane == 0) { if ((step & 1) == 0) dbg_report(ctl, step, bf2f(((const bf16*)(ws + WS_GS))[(size_t)m * DM + n]), gl, lane);
                else if (b < 2) dbg_report(ctl, step, ((const float*)(ws + WS_T))[(size_t)m * DM + n], tsum, lane);
                else dbg_report(ctl, step, bf2f(U[U_MG + (size_t)m * DM + n]), tsum, lane); } }
        return; }
    const int l = check >= 16 ? 1 : 0; check &= 15; const int rb01 = (l == 1) ? 3 : check;
  for (int rep = 0; rep < 4; ++rep) {
    const int m = 10168 + (gw & 7); const int ci = cond_of_row(m); const int sidx = (gw >> 3) + 256 * rep;
    if (check == 0) {
        if (rep > 0) continue;
        const int h = sidx & 3;
        const bf16* xn = XN + (size_t)m * DM; const float* W = A.in[I_WIN] + (size_t)l * DM * NIN_SRC;
        float q0 = 0.f, q1 = 0.f;
        for (int d = 0; d < 128; ++d) { float a = 0.f; for (int k = lane; k < DM; k += 64) a += bf2f(xn[k]) * bf2f((unsigned short)f2bf(W[(size_t)k * NIN_SRC + h * 128 + d])); const float v = bf2f((unsigned short)f2bf(wave_sum(a))); if (d == lane) q0 = v; if (d == lane + 64) q1 = v; }
        int mb, T, n; const float* S0f = nullptr; const float* S0b = nullptr;
        if (m < MCTX) { mb = m & ~255; T = 256; n = m & 255; } else { const int bb = (m - MCTX) >> 12; mb = MCTX + bb * SEQL; T = SEQL; n = (m - MCTX) & (SEQL - 1);
            S0f = A.in[I_STATE] + ((size_t)(((bb * 2 + l) * 2 + 0) * 4 + h) * 16384); S0b = A.in[I_STATE] + ((size_t)(((bb * 2 + l) * 2 + 1) * 4 + h) * 16384); }
        const float xf = A.in[I_DECAY][(l * 2 + 0) * 4 + h], xb = A.in[I_DECAY][(l * 2 + 1) * 4 + h];
        const float lgf = -logf(1.0f + __expf(-xf)), lgb = -logf(1.0f + __expf(-xb));
        float o0 = 0.f, o1 = 0.f;
        for (int j = 0; j < T; ++j) {
            const bf16* kr = U + U_RK + (size_t)(mb + j) * 512 + h * 128; const bf16* vr = U + U_RV + (size_t)(mb + j) * 512 + h * 128;
            const float sdot = wave_sum(q0 * bf2f(kr[lane]) + q1 * bf2f(kr[lane + 64])) * RET_SCALE;
            const float w = (j < n) ? __expf(lgf * (float)(n - j)) : ((j > n) ? __expf(lgb * (float)(j - n)) : 2.0f);
            o0 += w * sdot * bf2f(vr[lane]); o1 += w * sdot * bf2f(vr[lane + 64]);
        }
        if (S0f) { const float df = __expf(lgf * (float)(n + 1)), db = __expf(lgb * (float)(T - n));
            for (int d = 0; d < 128; ++d) { const float qd = __shfl(d < 64 ? q0 : q1, d & 63);
                o0 += qd * (df * S0f[d * 128 + lane] + db * S0b[d * 128 + lane]); o1 += qd * (df * S0f[d * 128 + lane + 64] + db * S0b[d * 128 + lane + 64]); } }
        const float r = 1.0f / sqrtf(wave_sum(o0 * o0 + o1 * o1) / 128.0f + EPS);
        const float* gn = A.in[I_RETGN] + l * 512 + h * 128;
        const float r0 = o0 * r * gn[lane] * bf2f(U[U_SRG + (size_t)m * 512 + h * 128 + lane]), r1 = o1 * r * gn[lane + 64] * bf2f(U[U_SRG + (size_t)m * 512 + h * 128 + lane + 64]);
        { const int slot = rb01; dbg_report(ctl, slot, bf2f(U[U_RQ + (size_t)m * 512 + h * 128 + lane]), r0, lane); dbg_report(ctl, slot, bf2f(U[U_RQ + (size_t)m * 512 + h * 128 + lane + 64]), r1, lane); }
    } else if (check == 1) {
        if (rep > 0) continue;
        const int h = sidx & 7, kv = h >> 2; const float q = dbg_qk_dim(A, ws, l, m, h, lane) * 0.125f;
        const bf16* Kb; const bf16* Vb; int S;
        if (m < MCTX) { const int bb = m >> 8; S = 256; Kb = (const bf16*)(ws + WS_KC) + (size_t)(bb * 2 + kv) * 256 * 64; Vb = (const bf16*)(ws + WS_VC) + (size_t)(bb * 2 + kv) * 256 * 64; }
        else { const int bb = (m - MCTX) >> 12; S = SKL; Kb = (const bf16*)(ws + WS_KL) + (size_t)((l * 2 + bb) * 2 + kv) * SKL * 64; Vb = (const bf16*)(ws + WS_VL) + (size_t)((l * 2 + bb) * 2 + kv) * SKL * 64; }
        float mx = -1e30f; for (int j = 0; j < S; ++j) mx = fmaxf(mx, wave_sum(q * bf2f(Kb[(size_t)j * 64 + lane])));
        float den = 0.f, o = 0.f; for (int j = 0; j < S; ++j) { const float p = __expf(wave_sum(q * bf2f(Kb[(size_t)j * 64 + lane])) - mx); den += p; o += p * bf2f(Vb[(size_t)j * 64 + lane]); }
        dbg_report(ctl, rb01, bf2f(U[U_AQ + (size_t)m * 512 + h * 64 + lane]), o / den, lane);
    } else if (check == 2) {
        const int n = sidx % DM; const float* W = A.in[I_WIN] + (size_t)l * DM * NIN_SRC; float ref = 0.f; float term[3];
        for (int b = 0; b < 3; ++b) { const float g = dbg_dot(XN + (size_t)m * DM, W, DM, NIN_SRC, NINM + 1024 * b + n, lane);
            const bf16* Ab = U + (b == 0 ? U_RQ : (b == 1 ? U_AQ : U_CB)) + (size_t)m * 512;
            const float* Wo = (b == 0 ? A.in[I_WRO] : (b == 1 ? A.in[I_WAO] : A.in[I_WCO])) + (size_t)l * 512 * DM;
            term[b] = dbg_sig(g) * dbg_dot(Ab, Wo, 512, DM, n, lane); ref += term[b]; }
        if (lane == 0) { dbg_report(ctl, 2, bf2f(U[U_MG + (size_t)m * DM + n]), ref, lane);
            const float got = bf2f(U[U_MG + (size_t)m * DM + n]); if (!(fabsf(got - ref) <= 0.05f * fabsf(ref) + 0.05f)) { atomicAdd(ctl + CW_DBG + 60, 1u);
                for (int b = 0; b < 3; ++b) { const float alt = ref - term[b]; if (fabsf(got - alt) <= 0.05f * fabsf(alt) + 0.05f) atomicAdd(ctl + CW_DBG + 50 + b, 1u); }
                const float gs = bf2f(((const bf16*)(ws + WS_GS))[(size_t)m * DM + n]); const float tt = ((const float*)(ws + WS_T))[(size_t)m * DM + n];
                const float t01 = term[0] + term[1]; if (!(fabsf(tt - t01) <= 0.05f * fabsf(t01) + 0.05f)) atomicAdd(ctl + CW_DBG + 53, 1u);
                const float g2 = dbg_sig(dbg_dot(XN + (size_t)m * DM, W, DM, NIN_SRC, NINM + 2048 + n, lane)); (void)g2; } }
    } else if (check == 3) {
        if (rep > 0) continue;
        float* T = (float*)(ws + WS_T); for (size_t i = (size_t)F.bx * 512 + F.tid; i < (size_t)MTOK * DM; i += (size_t)F.G * 512) T[i] = A.out[i];
    } else if (check == 4) {
        const int n = sidx % DM; const float* T = (const float*)(ws + WS_T);
        const float d = dbg_dot(U + U_MG + (size_t)m * DM, A.in[I_WO] + (size_t)l * DM * DM, DM, DM, n, lane);
        const float ref = T[(size_t)m * DM + n] + mod[(size_t)(ci * 2 + l) * 9216 + 5 * 1024 + n] * d;
        if (lane == 0) dbg_report(ctl, 4, A.out[(size_t)m * DM + n], ref, lane);
    } else if (check == 5 || check == 9) {
        const int j = check == 5 ? 2 : 0; const float* x = A.out + (size_t)m * DM;
        float s2 = 0.f; for (int k = lane; k < DM; k += 64) s2 += x[k] * x[k];
        s2 = wave_sum(s2); const float rstd = 1.0f / sqrtf(s2 / DM + EPS);
        const int k = lane * 16 + 3; const float* mm = mod + (size_t)(ci * 2 + l) * 9216 + 3 * j * 1024;
        const float ref = x[k] * rstd * A.in[I_NORMW][(l * 3 + j) * DM + k] * (1.0f + mm[1024 + k]) + mm[k];
        dbg_report(ctl, check, bf2f(XN[(size_t)m * DM + k]), ref, lane);
    } else if (check == 6 || check == 10) {
        const int f = check == 6 ? 1 : 0; const int j = (gw * 131 + 5) % FFN; const float* W = A.in[I_WFFIN] + (size_t)(l * 2 + f) * DM * NFF1;
        const float g = dbg_dot(XN + (size_t)m * DM, W, DM, NFF1, j, lane), u = dbg_dot(XN + (size_t)m * DM, W, DM, NFF1, FFN + j, lane);
        if (lane == 0) dbg_report(ctl, check, bf2f(U[(size_t)m * FFN + j]), g * dbg_sig(g) * u, lane);
    } else if (check == 7) {
        const int n = (gw * 61 + 3) % DM; const float* T = (const float*)(ws + WS_T);
        const float d = dbg_dot(U + (size_t)m * FFN, A.in[I_WFFOUT] + (size_t)(l * 2 + 1) * FFN * DM, FFN, DM, n, lane);
        const float ref = T[(size_t)m * DM + n] + 0.5f * mod[(size_t)(ci * 2 + l) * 9216 + 8 * 1024 + n] * d;
        if (lane == 0) dbg_report(ctl, 7, A.out[(size_t)m * DM + n], ref, lane);
    } else if (check == 11) {
        float mx = 0.f; for (size_t i = (size_t)F.bx * 512 + F.tid; i < (size_t)MTOK * DM; i += (size_t)F.G * 512) { const float v = fabsf(A.out[i]); mx = fmaxf(mx, (v == v) ? v : 1e30f); }
        mx = fmaxf(mx, __shfl_xor(mx, 1)); mx = fmaxf(mx, __shfl_xor(mx, 2)); mx = fmaxf(mx, __shfl_xor(mx, 4)); mx = fmaxf(mx, __shfl_xor(mx, 8)); mx = fmaxf(mx, __shfl_xor(mx, 16)); mx = fmaxf(mx, __shfl_xor(mx, 32));
        if (lane == 0) atomicMax(ctl + CW_DBG + 40, __float_as_uint(mx));
    } else if (check == 13) {
        for (int p = 0; p < 3; ++p) { const bf16* P = U + (p == 0 ? U_RQ : (p == 1 ? U_AQ : U_CB)); float mx = 0.f;
            for (size_t i = (size_t)F.bx * 512 + F.tid; i < PLANE; i += (size_t)F.G * 512) { const float v = fabsf(bf2f(P[i])); mx = fmaxf(mx, (v == v) ? v : 1e30f); }
            mx = fmaxf(mx, __shfl_xor(mx, 1)); mx = fmaxf(mx, __shfl_xor(mx, 2)); mx = fmaxf(mx, __shfl_xor(mx, 4)); mx = fmaxf(mx, __shfl_xor(mx, 8)); mx = fmaxf(mx, __shfl_xor(mx, 16)); mx = fmaxf(mx, __shfl_xor(mx, 32));
            if (lane == 0) atomicMax(ctl + CW_DBG + 44 + p, __float_as_uint(mx)); }
    } else if (check == 14) {
        const float mxv = __uint_as_float(ctl[CW_DBG + 40]);
        for (size_t i = (size_t)F.bx * 512 + F.tid; i < (size_t)MTOK * DM; i += (size_t)F.G * 512) { const float v = fabsf(A.out[i]); if (v >= 0.999f * mxv) atomicMax(ctl + CW_DBG + 47, 0x7fffffffu - (unsigned)i); }
    } else if (check == 12) {
        if (F.bx == 0 && F.tid == 0) { const float mx = __uint_as_float(ctl[CW_DBG + 40]); if (mx > 30.f && ctl[CW_DBG + 41] == 0u) { ctl[CW_DBG + 41] = 1u + ctl[CW_DBG + 42]; ctl[CW_DBG + 43] = __float_as_uint(mx); } ctl[CW_DBG + 42] += 1u; }
    } else if (check == 8) {
        int c = (sidx * 4 + (gw & 3)) % NINM; if (c >= 3840) c -= 512;
        const float* W = A.in[I_WIN] + (size_t)l * DM * NIN_SRC;
        float ref = dbg_dot(XN + (size_t)m * DM, W, DM, NIN_SRC, c, lane), got;
        if (c < 512) got = bf2f(U[U_RQ + (size_t)m * 512 + c]);
        else if (c < 1024) got = bf2f(U[U_RK + (size_t)m * 512 + c - 512]);
        else if (c < 1536) got = bf2f(U[U_RV + (size_t)m * 512 + c - 1024]);
        else if (c < 2048) { got = bf2f(U[U_SRG + (size_t)m * 512 + c - 1536]); ref = ref * dbg_sig(ref); }
        else if (c < 2560) got = bf2f(U[U_AQ + (size_t)m * 512 + c - 2048]);
        else if (c < 2816) got = bf2f(U[U_AKV + (size_t)m * 256 + c - 2560]);
        else if (c < 3328) got = bf2f(U[U_CB + (size_t)m * 512 + c - 2816]);
        else { ref *= dbg_dot(XN + (size_t)m * DM, W, DM, NIN_SRC, c + 512, lane); got = bf2f(U[U_P + (size_t)m * 512 + c - 3328]); }
        if (lane == 0) dbg_report(ctl, 8, got, ref, lane);
    }
  }
}
__device__ __forceinline__ void dbg_final(Frame& F) {
    CArgs& A = *get_args(); unsigned* ctl = (unsigned*)(A.ws + WS_CTL);
    if (F.bx == 0 && F.tid == 0) {
        const unsigned mask = ctl[CW_DBG];
#if DBG == 2
        const unsigned same_all = (ctl[CW_DBG + 100] == ctl[CW_DBG + 101]) ? 1u : 0u, same_foc = (ctl[CW_DBG + 102] == ctl[CW_DBG + 103]) ? 1u : 0u;
        (void)same_all; (void)same_foc;
        const unsigned tot = ctl[CW_DBG + 60]; int lb = 0; { unsigned t = 1; while (lb < 14 && tot >= t) { ++lb; t <<= 1; } }
        const float mxx = __uint_as_float(ctl[CW_DBG + 61]); int bx2 = 0; { float t = 2.f; while (bx2 < 20 && mxx >= t) { ++bx2; t *= 2.f; } }
        const unsigned tot2 = ctl[CW_DBG + 62]; int lb2 = 0; { unsigned t = 1; while (lb2 < 9 && tot2 >= t) { ++lb2; t <<= 1; } }
        { const unsigned tot = ctl[CW_DBG + 200]; int lb = 0; { unsigned t = 1; while (lb < 30 && tot >= t) { ++lb; t <<= 1; } }
          int ntile = 0; for (int q = 0; q < 64; ++q) ntile += ctl[CW_DBG + 256 + q] ? 1 : 0; int nrow = 0; for (int q = 0; q < 256; ++q) nrow += ctl[CW_DBG + 384 + q] ? 1 : 0;
          int lr = 0; { int t = 1; while (lr < 9 && nrow >= t) { ++lr; t <<= 1; } }
#if DBG_WHICH == 0
          int minr = 255, maxr = 0; for (int q = 0; q < 256; ++q) if (ctl[CW_DBG + 384 + q] > 8u) { if (q < minr) minr = q; if (q > maxr) maxr = q; }
          { const unsigned bad = ctl[CW_DBG + 210], good = ctl[CW_DBG + 211]; int l1 = 0, l2 = 0; { unsigned t = 1; while (l1 < 30 && bad >= t) { ++l1; t <<= 1; } } { unsigned t = 1; while (l2 < 30 && good >= t) { ++l2; t <<= 1; } }
            float v = (float)(10 + l1) * 1e4f; for (int i = 0; i < l2; ++i) v *= 10.0f; A.out[0] = v; return; }
          (void)ntile; (void)lb; (void)minr; (void)maxr; int c4[4]; for (int g = 0; g < 4; ++g) { c4[g] = 0; for (int q = 0; q < 4; ++q) c4[g] += (ctl[CW_DBG + 384 + 176 + 4 * g + q] > 8u) ? 1 : 0; }
          int nall = 0; for (int q = 0; q < 256; ++q) nall += (ctl[CW_DBG + 384 + q] > 8u) ? 1 : 0;
          float v = (float)(10 + c4[0] * 5 + c4[1]) * 1e4f; for (int i = 0; i < c4[2] * 5 + c4[3]; ++i) v *= 10.0f; if (nall != 24) v = -v; A.out[0] = v; return;
#else
          const unsigned b0 = ctl[CW_DBG + 201], b1c = ctl[CW_DBG + 202]; int l0 = 0; { unsigned t = 1; while (l0 < 30 && b0 >= t) { ++l0; t <<= 1; } } (void)b1c;
          float v = (float)(10 + lr * 9) * 1e4f; for (int i = 0; i < l0; ++i) v *= 10.0f; A.out[0] = v; return;
#endif
        }
        const unsigned g128 = ctl[CW_DBG + 110] & 255u, g8 = ctl[CW_DBG + 111] & 0xffffu, g1 = ctl[CW_DBG + 112] & 255u;
#if DBG_WHICH == 0
        float v = (float)(10u + (g128 & 63u)) * 1e4f; for (unsigned i = 0; i < (g128 >> 6) + 4u * (g1 == 255u ? 1u : 0u); ++i) v *= 10.0f; A.out[0] = v;
#else
        float v = (float)(10u + (g8 & 63u)) * 1e4f; for (unsigned i = 0; i < (g8 >> 6); ++i) v *= 10.0f; A.out[0] = v;
#endif
#else
        float v = (float)(10u + (mask & 63u)) * 1e4f; for (unsigned i = 0; i < (mask >> 6); ++i) v *= 10.0f;
        A.out[0] = v;
#endif
    }
}
#endif

enum { K_PRO = 0, K_NORM, K_FFN_UP, K_FFN_DOWN, K_WIN, K_MIX1, K_SCAN, K_MIX2, K_MERGE, K_WO, K_XLAYER };
constexpr int N_PHASES = 27;
__device__ __forceinline__ void decode_phase(int ph, int& kind, int& l, int& sub) {
    if (ph >= 3000) { kind = 98; l = 0; sub = ph - 3000; return; }
    if (ph >= 1000) { kind = 99; l = 0; sub = ph - 1000; return; }
    if (ph == 0) { kind = K_PRO; l = 0; sub = 0; return; }
    if (ph == 1) { kind = K_NORM; l = 0; sub = 0; return; }
    const int q = ph - 2; l = q / 13; const int r = q % 13; sub = 0;
    switch (r) {
        case 0: kind = K_FFN_UP; sub = 0; break;
        case 1: kind = K_FFN_DOWN; sub = 0; break;
        case 2: kind = K_NORM; sub = 1; break;
        case 3: kind = K_WIN; break;
        case 4: kind = K_MIX1; break;
        case 5: kind = K_SCAN; break;
        case 6: kind = K_MIX2; break;
        case 7: kind = K_MERGE; break;
        case 8: kind = K_WO; break;
        case 9: kind = K_NORM; sub = 2; break;
        case 10: kind = K_FFN_UP; sub = 1; break;
        case 11: kind = K_FFN_DOWN; sub = 1; break;
        default: kind = K_XLAYER; break;
    }
}

__device__ __forceinline__ void ph_ffn_up(Frame& F, int f) {
    CArgs& A = *get_args(); unsigned char* const ws = A.ws;
    pg8::Gemm g{(const pg8::bf16_t*)(ws + WS_XN), (const pg8::bf16_t*)(ws + WS_WFF1) + (size_t)f * NFF1 * DM, MTOK, NFF1, DM};
    pg8::StaticOrder S; S.init(MTOK, NFF1, F.G, F.bx);
    pg8::EpiPair<1> E{(pg8::bf16_t*)(ws + WS_R1), FFN, 0};
    if (EN_UP) pg8::gemm_phase(F.lds, g, S, E, F.tid);
}
__device__ __forceinline__ void ph_resid(Frame& F, int l, int f, bool wo) {
    CArgs& A = *get_args(); unsigned char* const ws = A.ws;
    const pg8::bf16_t* R1 = (const pg8::bf16_t*)(ws + WS_R1);
    pg8::Gemm g{wo ? R1 + U_MG : R1, wo ? (const pg8::bf16_t*)(ws + WS_WO) : (const pg8::bf16_t*)(ws + WS_WFF2) + (size_t)f * DM * FFN, MTOK, DM, wo ? DM : FFN};
    pg8::StaticOrder S; S.init(MTOK, DM, F.G, F.bx);
    const bool first = (!wo && l == 0 && f == 0);
    const int gj = wo ? 5 : (f == 0 ? 2 : 8);
    float* outp = A.out;
    const float* mod = (const float*)(ws + WS_MOD);
    pg8::EpiResid E{first ? A.in[I_XP] : outp, first ? A.in[I_XS] : outp + (size_t)MCTX * DM, outp, mod + (size_t)l * 9216 + gj * 1024, 2 * 9216, wo ? 1.0f : 0.5f};
    if (EN_DOWN) pg8::gemm_phase(F.lds, g, S, E, F.tid);
}
__device__ __forceinline__ void ph_win(Frame& F) {
    CArgs& A = *get_args(); unsigned char* const ws = A.ws;
    pg8::Gemm g{(const pg8::bf16_t*)(ws + WS_XN), (const pg8::bf16_t*)(ws + WS_WINM), MTOK, NINM, DM};
    pg8::StaticOrder S; S.init(MTOK, NINM, F.G, F.bx);
    pg8::EpiWin E{(pg8::bf16_t*)(ws + WS_R1)};
    if (EN_WIN) pg8::gemm_phase(F.lds, g, S, E, F.tid);
}
__device__ __forceinline__ void ph_merge(Frame& F) {
    for (int b = 0; b < 3; ++b) {
        { CArgs& A = *get_args(); unsigned char* const ws = A.ws;
          pg8::Gemm g{(const pg8::bf16_t*)(ws + WS_XN), (const pg8::bf16_t*)(ws + WS_WG) + (size_t)b * DM * DM, MTOK, DM, DM};
          pg8::StaticOrder S; S.init(MTOK, DM, F.G, F.bx);
          pg8::EpiSig E{(pg8::bf16_t*)(ws + WS_GS), nullptr};
          if (EN_SIG) pg8::gemm_phase(F.lds, g, S, E, F.tid); }
        { CArgs& A = *get_args(); unsigned char* const ws = A.ws;
          pg8::bf16_t* R1 = (pg8::bf16_t*)(ws + WS_R1);
          const pg8::bf16_t* Ab = R1 + (b == 0 ? U_RQ : (b == 1 ? U_AQ : U_CB));
          pg8::Gemm g{Ab, (const pg8::bf16_t*)(ws + WS_WRO) + (size_t)b * DM * 512, MTOK, DM, 512};
          pg8::StaticOrder S; S.init(MTOK, DM, F.G, F.bx);
          pg8::EpiMerge E{(const pg8::bf16_t*)(ws + WS_GS), (float*)(ws + WS_T), R1 + U_MG, b};
          if (EN_MERGE) pg8::gemm_phase(F.lds, g, S, E, F.tid); }
    }
}
__device__ __forceinline__ void relaunder(Frame& F) {
    int t = threadIdx.x; asm volatile("" : "+v"(t)); F.tid = t; F.lane = t & 63; F.wave = __builtin_amdgcn_readfirstlane(t >> 6);
    int bx = blockIdx.x, G = gridDim.x; asm volatile("" : "+s"(bx), "+s"(G)); F.G = G; F.vcu = (G % 8 == 0) ? (bx % 8) * (G / 8) + bx / 8 : bx; F.bx = bx;
}
__device__ __forceinline__ void grid_barrier(Frame& F, unsigned bar_x) {
    CArgs* A2 = get_args();
    unsigned bxx = bar_x; asm volatile("" : "+s"(bxx));
    XcdBarrier bar; bar.bar = (unsigned*)(A2->ws + WS_CTL) + CW_BAR; bar.x = bxx; bar.st = (volatile LAS unsigned*)(F.lds + MISC_OFF) + 8;
    xcd_barrier(bar, F.tid);
}
#if TPROBE
#define TSTAMP(k) do { if (blockIdx.x == 0 && threadIdx.x == 0) { CArgs* A3 = get_args(); ((unsigned long long*)(A3->ws + WS_CTL + 65536))[(k) + 1] = __builtin_amdgcn_s_memrealtime(); } } while (0)
#else
#define TSTAMP(k) do { } while (0)
#endif
#define PHASE(k, ...) do { if (ph_lo <= (k) && (k) < ph_hi) { relaunder(F); __VA_ARGS__; if ((k) + 1 < ph_hi || TPROBE) grid_barrier(F, bar_x); TSTAMP(k); } } while (0)
#define LAYER(l, base) \
    PHASE((base) + 0, ph_ffn_up(F, 0)); \
    PHASE((base) + 1, ph_resid(F, l, 0, false)); \
    PHASE((base) + 2, modnorm_rows(F, l, 1, false)); \
    PHASE((base) + 3, ph_win(F)); \
    PHASE((base) + 4, if (EN_MIX1) { qk_pass(F, l); conv_pass(F, l); if (USE_MFMA_RET) ret_pass1_mfma(F, l); else ret_pass1(F, l); }); \
    PHASE((base) + 5, ret_scan(F, l)); \
    PHASE((base) + 6, if (EN_RET3) { if (USE_MFMA_RET) ret_pass3_mfma(F, l); else ret_pass3(F, l); } if (EN_ATTN) { if (USE_MFMA_ATTN) attn_mfma(F, l); else attn_naive(F, l); }); \
    PHASE((base) + 7, ph_merge(F)); \
    PHASE((base) + 8, ph_resid(F, l, 0, true)); \
    PHASE((base) + 9, modnorm_rows(F, l, 2, false)); \
    PHASE((base) + 10, ph_ffn_up(F, 1)); \
    PHASE((base) + 11, ph_resid(F, l, 1, false))

__global__ void __launch_bounds__(NWAVES * 64, 2) trunk_fwd(Args args_unused) {
    extern __shared__ __attribute__((aligned(16))) unsigned char lds[];
    Frame F;
    F.lds = (LAS unsigned char*)lds;
    { const int t0 = threadIdx.x; for (int u = t0; u < (LDS_BYTES - RING_BYTES) / 4; u += NWAVES * 64) ((LAS unsigned*)(F.lds + RING_BYTES))[u] = 0u; }
    __syncthreads();
    int ph_lo, ph_hi; { CArgs* A0 = get_args(); ph_lo = A0->ph_lo; ph_hi = A0->ph_hi; }
    unsigned bar_x = 0;
    if (ph_hi - ph_lo > 1) { CArgs* A0 = get_args(); XcdBarrier b0 = xcd_barrier_post((unsigned*)(A0->ws + WS_CTL) + CW_BAR, (volatile LAS unsigned*)(F.lds + MISC_OFF) + 8); bar_x = b0.x; }
#if TPROBE
    if (blockIdx.x == 0 && threadIdx.x == 0) { CArgs* A3 = get_args(); ((unsigned long long*)(A3->ws + WS_CTL + 65536))[0] = __builtin_amdgcn_s_memrealtime(); }
#endif
#if DBG
    if (ph_lo >= 1000) { relaunder(F); int kind, l, sub; decode_phase(ph_lo, kind, l, sub); if (kind == 99) { if (sub == 999) dbg_final(F); else dbg_checks(F, sub); } return; }
#endif
    PHASE(0, if (EN_PRO) { compute_mod(F); prologue_misc(F); __syncthreads(); convert_weights(F, 0); });
    PHASE(1, modnorm_rows(F, 0, 0, true));
    LAYER(0, 2);
    PHASE(14, convert_weights(F, 1); modnorm_rows(F, 1, 0, false));
    LAYER(1, 15);
#if TPROBE
    if (blockIdx.x == 0 && threadIdx.x == 0) { CArgs* A3 = get_args(); const unsigned long long* ts = (const unsigned long long*)(A3->ws + WS_CTL + 65536);
        float sum[12]; for (int k = 0; k < 12; ++k) sum[k] = 0.f; float tot = 0.f;
        for (int ph = 0; ph < N_PHASES; ++ph) { int kind, l, sub; decode_phase(ph, kind, l, sub); const float d = (float)(ts[ph + 1] - ts[ph]); tot += d; sum[kind < 12 ? kind : 11] += d; }
        const int ka = (TPROBE >> 4) & 15, kb = TPROBE & 15; const float pa = 100.f * sum[ka] / tot, pb = 100.f * sum[kb] / tot;
        int ia = (int)(pa * 0.5f + 0.5f) * 2; if (ia > 88) ia = 88; int ib = (int)(pb * 0.5f + 0.5f) * 2; if (ib > 30) ib = 30;
        float v = (float)(10 + ia) * 1e4f; for (int i = 0; i < ib; ++i) v *= 10.0f; A3->out[0] = v; }
#endif
}

extern "C" void kernel_launch(void* const* d_in, const int* in_sizes, int n_in, void* d_out, int out_size, void* d_ws, size_t ws_size, hipStream_t stream) {
    static int grid = 0;
    if (grid == 0) {
        if (n_in != 22 || out_size != OUT_TOTAL || ws_size < WS_END) { fprintf(stderr, "kernel_launch: unexpected shapes: n_in %d out %d ws %zu (need %zu)\n", n_in, out_size, ws_size, (size_t)WS_END); grid = -1; return; }
        int dev = 0, cus = 0;
        if (hipGetDevice(&dev) != hipSuccess || hipDeviceGetAttribute(&cus, hipDeviceAttributeMultiprocessorCount, dev) != hipSuccess) { grid = -1; return; }
        if (hipFuncSetAttribute((const void*)trunk_fwd, hipFuncAttributeMaxDynamicSharedMemorySize, LDS_BYTES) != hipSuccess) { fprintf(stderr, "kernel_launch: hipFuncSetAttribute failed\n"); grid = -1; return; }
        int per_cu = 0;
        if (hipOccupancyMaxActiveBlocksPerMultiprocessor(&per_cu, (const void*)trunk_fwd, NWAVES * 64, LDS_BYTES) != hipSuccess || per_cu < 1) fprintf(stderr, "kernel_launch: occupancy query says %d\n", per_cu);
        (void)hipGetLastError();
        grid = cus;
    }
    if (grid < 0) return;
    (void)hipMemsetAsync((char*)d_ws + WS_CTL, 0, CTL_ZERO_BYTES, stream);
    Args a{};
    for (int i = 0; i < 22; ++i) a.in[i] = (const float*)d_in[i];
    a.out = (float*)d_out; a.ws = (unsigned char*)d_ws;
#if MK_MULTI_LAUNCH
    for (int ph = 0; ph < N_PHASES; ++ph) {
#if DBG
        if (0) { a.ph_lo = 1041; a.ph_hi = a.ph_lo + 1; hipLaunchKernelGGL(trunk_fwd, dim3(grid), dim3(NWAVES * 64), LDS_BYTES, stream, a); }
        if (0) { a.ph_lo = 1030 + (ph == 9 ? 1 : 0); a.ph_hi = a.ph_lo + 1; hipLaunchKernelGGL(trunk_fwd, dim3(grid), dim3(NWAVES * 64), LDS_BYTES, stream, a); }
        if (ph == 9) { for (int st = 0; st < 6; ++st) { a.ph_lo = 3000 + st; a.ph_hi = a.ph_lo + 1; hipLaunchKernelGGL(trunk_fwd, dim3(grid), dim3(NWAVES * 64), LDS_BYTES, stream, a);
                if (st == 0) { a.ph_lo = 1040; a.ph_hi = a.ph_lo + 1; hipLaunchKernelGGL(trunk_fwd, dim3(grid), dim3(NWAVES * 64), LDS_BYTES, stream, a); } } continue; }
#endif
        a.ph_lo = ph; a.ph_hi = ph + 1; hipLaunchKernelGGL(trunk_fwd, dim3(grid), dim3(NWAVES * 64), LDS_BYTES, stream, a);
#if DBG
        static const int after[][2] = {{8, 0}, {8, 1}, {9, 2}, {9, 3}, {10, 4}, {11, 5}, {12, 6}, {12, 3}, {13, 7}, {14, 16 + 9}, {15, 16 + 10}, {18, 16 + 8}, {21, 16 + 0}, {21, 16 + 1}};
        { static const int aft[][2] = {{5, 8}, {8, 0}, {8, 1}, {9, 2}, {9, 3}, {10, 4}};
          for (unsigned c = 0; c < 0; ++c) if (aft[c][0] == ph) { a.ph_lo = 1000 + aft[c][1]; a.ph_hi = a.ph_lo + 1; hipLaunchKernelGGL(trunk_fwd, dim3(grid), dim3(NWAVES * 64), LDS_BYTES, stream, a); } }
        if (0) { a.ph_lo = 1011; a.ph_hi = 1012; hipLaunchKernelGGL(trunk_fwd, dim3(grid), dim3(NWAVES * 64), LDS_BYTES, stream, a); a.ph_lo = 1012; a.ph_hi = 1013; hipLaunchKernelGGL(trunk_fwd, dim3(grid), dim3(NWAVES * 64), LDS_BYTES, stream, a); }
        for (unsigned c = 0; c < 0 * sizeof(after) / sizeof(after[0]); ++c) if (after[c][0] == ph) { a.ph_lo = 1000 + after[c][1]; a.ph_hi = a.ph_lo + 1; hipLaunchKernelGGL(trunk_fwd, dim3(grid), dim3(NWAVES * 64), LDS_BYTES, stream, a); }
#endif
    }
#if DBG
    a.ph_lo = 1999; a.ph_hi = 2000; hipLaunchKernelGGL(trunk_fwd, dim3(grid), dim3(NWAVES * 64), LDS_BYTES, stream, a);
#endif
#else
    a.ph_lo = 0; a.ph_hi = N_PHASES;
    hipLaunchKernelGGL(trunk_fwd, dim3(grid), dim3(NWAVES * 64), LDS_BYTES, stream, a);
#endif
}
```
